# Optimizing an MI355X kernel written in HIP

```python
import jax, jax.numpy as jnp
from jax import lax
import numpy as np

D_MODEL = 1024
BATCH = 2
SEQ = 8192
DEPTH = 4
DEC_BATCH = 32
DEC_SEQ = 1
PAST_LEN = 8192
PAGE_SIZE = 128

N_A_LAYERS = DEPTH // 2
N_B_LAYERS = DEPTH - N_A_LAYERS
D_FF = 4 * D_MODEL
CHUNK = 128
A_GROUP_DIM = 128
A_GROUPS = D_MODEL // A_GROUP_DIM
HEAD_DIM = 64
N_HEADS = D_MODEL // HEAD_DIM
N_KV = 4
Q_PER_KV = N_HEADS // N_KV
CMP_STRIDE = 16
CMP_LEN = 2 * CMP_STRIDE
CMP_HIDDEN = 4 * HEAD_DIM
SEL_LEN = 64
N_SEL = 16
WINDOW = 512
Q_BLOCK = 128
EPS = 1e-6
NEG_INF = -1e30
FORCE_SCORE = 1e6

kernel_name = 'yoco_gmlp_nsa_decoder_step'


def rmsnorm(x, g):
    x32 = x.astype(jnp.float32)
    y = x32 * lax.rsqrt(jnp.mean(x32 * x32, axis=-1, keepdims=True) + EPS)
    return (y * g.astype(jnp.float32)).astype(x.dtype)


def sq_relu_mlp(x, w_up, w_down):
    return jnp.square(jax.nn.relu(x @ w_up)) @ w_down


def masked_softmax(s, mask):
    s = jnp.where(mask, s.astype(jnp.float32), NEG_INF)
    return jnp.where(mask, jax.nn.softmax(s, axis=-1), 0.0)


def chunk_gmlp(xn, w_uv, v_norm_g, w_s, b_s, w_o):
    b, t, _ = xn.shape
    uv = xn @ w_uv
    u, v = uv[..., :D_MODEL], rmsnorm(uv[..., D_MODEL:], v_norm_g)
    n_chunk = -(-t // CHUNK)
    vp = jnp.pad(v, ((0, 0), (0, n_chunk * CHUNK - t), (0, 0)))
    vp = vp.reshape(b, n_chunk, CHUNK, A_GROUPS, A_GROUP_DIM)
    s = jnp.einsum('gts,bnsgc->bntgc', jnp.tril(w_s), vp) + b_s.T[None, None, :, :, None]
    s = s.reshape(b, n_chunk * CHUNK, D_MODEL)[:, :t]
    return (u * s) @ w_o, v


def shared_kv(h, kv_norm_g, w_kv):
    b, t, _ = h.shape
    kv = (rmsnorm(h, kv_norm_g) @ w_kv).reshape(b, t, 3, 2, N_KV, HEAD_DIM)
    return kv[:, :, 0], kv[:, :, 1], kv[:, :, 2]


def compress_rows(k, pe, w1, w2):
    b, t = k.shape[:2]
    n_cmp = (t - CMP_LEN) // CMP_STRIDE + 1
    kr = k[:, :(n_cmp + 1) * CMP_STRIDE].reshape(b, n_cmp + 1, CMP_STRIDE, N_KV, HEAD_DIM)
    blocks = jnp.concatenate([kr[:, :-1], kr[:, 1:]], axis=2) + pe[:, None, :]
    flat = jnp.swapaxes(blocks, 2, 3).reshape(b, n_cmp, N_KV, CMP_LEN * HEAD_DIM)
    return jax.nn.gelu(flat @ w1) @ w2


def selection_map(n_cmp, n_blk):
    i = np.arange(n_cmp)[:, None]
    j = np.arange(n_blk)[None, :]
    lo = np.maximum(i * CMP_STRIDE, j * SEL_LEN)
    hi = np.minimum(i * CMP_STRIDE + CMP_LEN, (j + 1) * SEL_LEN)
    return jnp.asarray(np.maximum(hi - lo, 0) // CMP_STRIDE, dtype=jnp.float32)


def nsa_key_side(cmp_kv, sel_kv, pe_k, w1_k, w2_k, pe_v, w1_v, w2_v):
    b, t = cmp_kv.shape[:2]
    kc = compress_rows(cmp_kv[:, :, 0], pe_k, w1_k, w2_k)
    vc = compress_rows(cmp_kv[:, :, 1], pe_v, w1_v, w2_v)
    n_cmp = kc.shape[1]
    cend = jnp.arange(n_cmp, dtype=jnp.int32) * CMP_STRIDE + (CMP_LEN - 1)
    n_blk = -(-t // SEL_LEN)
    sel = jnp.pad(sel_kv, ((0, 0), (0, n_blk * SEL_LEN - t), (0, 0), (0, 0), (0, 0)))
    sel = sel.reshape(b, n_blk, SEL_LEN, 2, N_KV, HEAD_DIM).transpose(3, 0, 4, 1, 2, 5)
    return kc, vc, cend, sel[0], sel[1], selection_map(n_cmp, n_blk)


def nsa_attend(q, gates, qpos, kc, vc, cend, ks_blk, vs_blk, smap, kw, vw, wpos):
    b, nq = q.shape[:2]
    scale = HEAD_DIM ** -0.5
    qg = q.reshape(b, nq, N_KV, Q_PER_KV, HEAD_DIM)
    s_c = jnp.einsum('bqgrd,bcgd->bqgrc', qg, kc) * scale
    m_c = (cend[None, :] <= qpos[:, None])[None, :, None, None, :]
    p_c = masked_softmax(s_c, m_c)
    o_c = jnp.einsum('bqgrc,bcgd->bqgrd', p_c.astype(vc.dtype), vc)
    n_blk = smap.shape[1]
    imp = jnp.einsum('bqgrc,cj->bqgj', p_c, smap)
    blk = jnp.arange(n_blk, dtype=jnp.int32)[None, :]
    cur = (qpos // SEL_LEN)[:, None]
    valid = blk <= cur
    forced = (blk == 0) | (blk == cur) | (blk == cur - 1)
    score = jnp.where(forced[None, :, None, :], FORCE_SCORE,
                      jnp.where(valid[None, :, None, :], imp, -1.0))
    top_s, top_i = lax.top_k(score, min(N_SEL, n_blk))
    n_top = top_i.shape[-1]
    ids = jnp.swapaxes(top_i, 1, 2).reshape(b, N_KV, nq * n_top)
    gather = jax.vmap(jax.vmap(lambda blocks, i: blocks[i]))
    k_sel = gather(ks_blk, ids).reshape(b, N_KV, nq, n_top, SEL_LEN, HEAD_DIM)
    v_sel = gather(vs_blk, ids).reshape(b, N_KV, nq, n_top, SEL_LEN, HEAD_DIM)
    tpos = top_i[..., None] * SEL_LEN + jnp.arange(SEL_LEN, dtype=jnp.int32)
    m_s = (tpos <= qpos[None, :, None, None, None]) & (top_s >= 0.0)[..., None]
    s_s = jnp.einsum('bqgrd,bgqkld->bqgrkl', qg, k_sel) * scale
    p_s = masked_softmax(s_s.reshape(b, nq, N_KV, Q_PER_KV, n_top * SEL_LEN),
                         m_s.reshape(b, nq, N_KV, 1, n_top * SEL_LEN))
    o_s = jnp.einsum('bqgrkl,bgqkld->bqgrd', p_s.reshape(s_s.shape).astype(v_sel.dtype), v_sel)
    s_w = jnp.einsum('bqgrd,bwgd->bqgrw', qg, kw) * scale
    dist = qpos[:, None] - wpos[None, :]
    m_w = ((dist >= 0) & (dist < WINDOW) & (wpos >= 0)[None, :])[None, :, None, None, :]
    p_w = masked_softmax(s_w, m_w)
    o_w = jnp.einsum('bqgrw,bwgd->bqgrd', p_w.astype(vw.dtype), vw)
    g = gates.reshape(b, nq, N_KV, Q_PER_KV, 3)
    o = g[..., 0:1] * o_c + g[..., 1:2] * o_s + g[..., 2:3] * o_w
    return o.reshape(b, nq, N_HEADS * HEAD_DIM)


def nsa_prompt(q, gates, ctx, win_pad):
    b, s = q.shape[:2]

    def one_block(n):
        s0 = n * Q_BLOCK
        qpos = s0 + jnp.arange(Q_BLOCK, dtype=jnp.int32)
        wpos = s0 - WINDOW + jnp.arange(WINDOW + Q_BLOCK, dtype=jnp.int32)
        win = lax.dynamic_slice_in_dim(win_pad, s0, WINDOW + Q_BLOCK, axis=1)
        return nsa_attend(lax.dynamic_slice_in_dim(q, s0, Q_BLOCK, axis=1),
                          lax.dynamic_slice_in_dim(gates, s0, Q_BLOCK, axis=1),
                          qpos, *ctx, win[:, :, 0], win[:, :, 1], wpos)

    out = lax.map(one_block, jnp.arange(s // Q_BLOCK, dtype=jnp.int32))
    return jnp.swapaxes(out, 0, 1).reshape(b, s, N_HEADS * HEAD_DIM)


def query_side(h, norm_g, w_qg, b_g):
    b, t, _ = h.shape
    z = rmsnorm(h, norm_g) @ w_qg
    q = z[..., :N_HEADS * HEAD_DIM].reshape(b, t, N_HEADS, HEAD_DIM)
    gates = jax.nn.sigmoid(z[..., N_HEADS * HEAD_DIM:] + b_g).reshape(b, t, N_HEADS, 3)
    return q, gates


def setup_inputs(seed: int = 0) -> dict:
    key = jax.random.key(seed)
    ks = iter(jax.random.split(key, 40))

    def nrm(shape, scale):
        return scale * jax.random.normal(next(ks), shape, jnp.float32)

    def gain(shape):
        return 1.0 + 0.02 * jax.random.normal(next(ks), shape, jnp.float32)

    n_pages = PAST_LEN // PAGE_SIZE
    n_used = DEC_BATCH * n_pages
    n_pool = n_used + max(1, n_used // 4)
    win_buf = min(WINDOW, PAST_LEN)
    kv_width = 6 * N_KV * HEAD_DIM
    qg_width = N_HEADS * HEAD_DIM + 3 * N_HEADS
    page_table = jax.random.permutation(next(ks), n_pool)[:n_used].reshape(DEC_BATCH, n_pages).astype(jnp.int32)
    return {
        'x_prompt': nrm((BATCH, SEQ, D_MODEL), 1.0),
        'x_sample': nrm((DEC_BATCH, DEC_SEQ, D_MODEL), 1.0),
        'cache_cmp_kv': nrm((n_pool, PAGE_SIZE, 2, N_KV, HEAD_DIM), 1.0),
        'cache_sel_kv': nrm((n_pool, PAGE_SIZE, 2, N_KV, HEAD_DIM), 1.0),
        'state_win_kv': nrm((DEC_BATCH, win_buf, 2, N_KV, HEAD_DIM), 1.0),
        'page_table': page_table,
        'a_norm_g': gain((N_A_LAYERS, D_MODEL)),
        'a_w_uv': nrm((N_A_LAYERS, D_MODEL, 2 * D_MODEL), D_MODEL ** -0.5),
        'a_v_norm_g': gain((N_A_LAYERS, D_MODEL)),
        'a_w_s': nrm((N_A_LAYERS, A_GROUPS, CHUNK, CHUNK), CHUNK ** -0.5),
        'a_b_s': gain((N_A_LAYERS, A_GROUPS, CHUNK)),
        'a_w_o': nrm((N_A_LAYERS, D_MODEL, D_MODEL), D_MODEL ** -0.5),
        'kv_norm_g': gain((D_MODEL,)),
        'w_kv': nrm((D_MODEL, kv_width), D_MODEL ** -0.5),
        'cmp_pe_k': nrm((CMP_LEN, HEAD_DIM), 0.1),
        'cmp_w1_k': nrm((CMP_LEN * HEAD_DIM, CMP_HIDDEN), (CMP_LEN * HEAD_DIM) ** -0.5),
        'cmp_w2_k': nrm((CMP_HIDDEN, HEAD_DIM), 1.5 * CMP_HIDDEN ** -0.5),
        'cmp_pe_v': nrm((CMP_LEN, HEAD_DIM), 0.1),
        'cmp_w1_v': nrm((CMP_LEN * HEAD_DIM, CMP_HIDDEN), (CMP_LEN * HEAD_DIM) ** -0.5),
        'cmp_w2_v': nrm((CMP_HIDDEN, HEAD_DIM), 1.5 * CMP_HIDDEN ** -0.5),
        'b_norm_g': gain((N_B_LAYERS, D_MODEL)),
        'b_w_qg': nrm((N_B_LAYERS, D_MODEL, qg_width), D_MODEL ** -0.5),
        'b_b_g': nrm((N_B_LAYERS, 3 * N_HEADS), 0.02),
        'b_w_o': nrm((N_B_LAYERS, N_HEADS * HEAD_DIM, D_MODEL), (N_HEADS * HEAD_DIM) ** -0.5),
        'mlp_norm_g': gain((DEPTH, D_MODEL)),
        'mlp_w_up': nrm((DEPTH, D_MODEL, D_FF), D_MODEL ** -0.5),
        'mlp_w_down': nrm((DEPTH, D_FF, D_MODEL), D_FF ** -0.5),
        'final_norm_g': gain((D_MODEL,)),
    }


def reference(x_prompt, x_sample, cache_cmp_kv, cache_sel_kv, state_win_kv, page_table,
              a_norm_g, a_w_uv, a_v_norm_g, a_w_s, a_b_s, a_w_o,
              kv_norm_g, w_kv, cmp_pe_k, cmp_w1_k, cmp_w2_k, cmp_pe_v, cmp_w1_v, cmp_w2_v,
              b_norm_g, b_w_qg, b_b_g, b_w_o,
              mlp_norm_g, mlp_w_up, mlp_w_down, final_norm_g):
    n_seq, n_pages = page_table.shape
    past_len = n_pages * cache_cmp_kv.shape[1]
    win_buf = state_win_kv.shape[1]
    seq = x_prompt.shape[1]
    dec_seq = x_sample.shape[1]
    cmp_w = (cmp_pe_k, cmp_w1_k, cmp_w2_k, cmp_pe_v, cmp_w1_v, cmp_w2_v)
    hp, hs = x_prompt, x_sample
    a_v_rows = []
    for layer in range(DEPTH):
        if layer == N_A_LAYERS:
            cmp_p, sel_p, win_p = shared_kv(hp, kv_norm_g, w_kv)
            cmp_s, sel_s, win_s = shared_kv(hs, kv_norm_g, w_kv)
            ctx_p = nsa_key_side(cmp_p, sel_p, *cmp_w)
            win_pad_p = jnp.pad(win_p, ((0, 0), (WINDOW, 0), (0, 0), (0, 0), (0, 0)))
            past_cmp = cache_cmp_kv[page_table].reshape(n_seq, past_len, 2, N_KV, HEAD_DIM)
            past_sel = cache_sel_kv[page_table].reshape(n_seq, past_len, 2, N_KV, HEAD_DIM)
            ctx_s = nsa_key_side(jnp.concatenate([past_cmp, cmp_s], axis=1),
                                 jnp.concatenate([past_sel, sel_s], axis=1), *cmp_w)
            win_full_s = jnp.concatenate([state_win_kv, win_s], axis=1)
            wpos_s = past_len - win_buf + jnp.arange(win_buf + dec_seq, dtype=jnp.int32)
            qpos_s = past_len + jnp.arange(dec_seq, dtype=jnp.int32)
        if layer < N_A_LAYERS:
            i = layer
            mix_p, _ = chunk_gmlp(rmsnorm(hp, a_norm_g[i]), a_w_uv[i], a_v_norm_g[i], a_w_s[i], a_b_s[i], a_w_o[i])
            mix_s, v_s = chunk_gmlp(rmsnorm(hs, a_norm_g[i]), a_w_uv[i], a_v_norm_g[i], a_w_s[i], a_b_s[i], a_w_o[i])
            a_v_rows.append(v_s)
        else:
            j = layer - N_A_LAYERS
            q_p, g_p = query_side(hp, b_norm_g[j], b_w_qg[j], b_b_g[j])
            q_s, g_s = query_side(hs, b_norm_g[j], b_w_qg[j], b_b_g[j])
            mix_p = nsa_prompt(q_p, g_p, ctx_p, win_pad_p) @ b_w_o[j]
            mix_s = nsa_attend(q_s, g_s, qpos_s, *ctx_s, win_full_s[:, :, 0], win_full_s[:, :, 1], wpos_s) @ b_w_o[j]
        hp = hp + mix_p
        hs = hs + mix_s
        hp = hp + sq_relu_mlp(rmsnorm(hp, mlp_norm_g[layer]), mlp_w_up[layer], mlp_w_down[layer])
        hs = hs + sq_relu_mlp(rmsnorm(hs, mlp_norm_g[layer]), mlp_w_up[layer], mlp_w_down[layer])
    y_prompt = rmsnorm(hp, final_norm_g)
    y_sample = rmsnorm(hs, final_norm_g)
    win_kv_prompt = win_p[:, seq - min(WINDOW, seq):]
    win_kv_sample = win_full_s[:, dec_seq:]
    a_v_sample = jnp.stack(a_v_rows, axis=0)
    return (y_prompt, y_sample, cmp_p, sel_p, win_kv_prompt, cmp_s, sel_s, win_kv_sample, a_v_sample)
```

```cpp
#include <hip/hip_runtime.h>
#include <cstdio>
#include <cstdint>
#ifndef MK_PER_PHASE
#define MK_PER_PHASE 0
#endif
namespace pg8 {
#define PG8_LAS __attribute__((address_space(3)))
typedef unsigned short bf16_t;
typedef short bf16x8 __attribute__((ext_vector_type(8)));
typedef float f32x4 __attribute__((ext_vector_type(4)));
typedef unsigned u32x4 __attribute__((ext_vector_type(4)));
constexpr int BM = 256, BK = 64, HALF = 128, HTB = HALF * BK * 2  , STAGE_BYTES = 8 * HTB, NXCD = 8, WGM = 8;

__host__ __device__ __forceinline__ int lds_byte(int r, int c) { const int st = (r >> 4) * 2 + (c >> 5), rr = r & 15, cc = c & 31, ob = rr * 64 + cc * 2; return st * 1024 + (ob ^ (((ob >> 9) & 1) << 5)); }
__host__ __device__ __forceinline__ void stage_rc(int b, int& R, int& C) { const int st = b / 1024, sb = b % 1024, swz = sb ^ (((sb >> 9) & 1) << 5); R = (st >> 1) * 16 + swz / 64; C = (st & 1) * 32 + (swz % 64) / 2; }
__host__ __device__ __forceinline__ int perm32(int rho) { const int n = rho >> 4, i = rho & 15; return 8 * (i >> 2) + 4 * n + (i & 3); }

struct Unit { int pm, pn; };
struct Gemm { const bf16_t* A; const bf16_t* Bt; int M, N, K; };

struct StaticOrder {
    int nM, nN, nwg, G, c;
    __host__ __device__ void init(int M, int N, int G_, int c_) { nM = M / BM; nN = N / BM; nwg = nM * nN; G = G_; c = c_; }
    __host__ __device__ bool next(int i, Unit& u) const {
        const long L = (long)i * G + c; if (L >= nwg) return false;
        int wgid = (int)L; { const int q = nwg / NXCD, r = nwg % NXCD, xcd = wgid % NXCD, off = wgid / NXCD; wgid = (xcd < r ? xcd * (q + 1) : r * (q + 1) + (xcd - r) * q) + off; }
        const int nig = WGM * nN, gid = wgid / nig, fm = gid * WGM, gsz = (nM - fm) < WGM ? (nM - fm) : WGM;
        u.pm = fm + ((wgid % nig) % gsz); u.pn = (wgid % nig) / gsz; return true;
    }
    __device__ __forceinline__ void a_ready(const Unit&) const {}
    __device__ __forceinline__ void done(const Unit&) const {}
};

}
namespace pg8 {
template <class Epi, class Sched, bool ALIGN_EPI = false, bool SP2 = false, int LDA = 0, int AJ = 0>
__device__ __forceinline__ void gemm_phase(PG8_LAS unsigned char* lds, const Gemm g, const Sched& S, const Epi& E) {
    int tid_l = threadIdx.x; asm volatile("" : "+v"(tid_l)); const int tid = tid_l, wid = __builtin_amdgcn_readfirstlane(tid >> 6), lane = tid & 63, wr = wid >> 2, wc = wid & 3, fr = lane & 15, fq = lane >> 4;
    const int K = g.K, nt = K / BK;
    unsigned voffA[2], voffB[2];
#pragma unroll
    for (int i = 0; i < 2; ++i) { int R, C; stage_rc(tid * 16 + i * 8192, R, C); const int Rb = Epi::PERM ? ((R & ~31) + perm32(R & 31)) : R;
        voffA[i] = (unsigned)(R * (LDA ? LDA : K) + C) * 2u; voffB[i] = (unsigned)(Rb * K + C) * 2u; }
    const size_t kstep = (size_t)(BK * 2);
    const size_t hstep = (size_t)HALF * K * 2;
    const size_t tstep = 2 * hstep;
    const size_t hstepA = LDA ? (size_t)HALF * LDA * 2 : hstep, tstepA = 2 * hstepA;
    const size_t ks1 = AJ ? (size_t)AJ : kstep, ks2 = AJ ? kstep : 2 * kstep;
    const unsigned ldsw = (unsigned)wid * 1024u;
    const int aoff = lds_byte(wr * 64 + fr, fq * 8), boff = lds_byte(wc * 32 + fr, fq * 8);
#define PG8_SA(b, h) (((b) * 2 + (h)) * HTB)
#define PG8_SB(b, h) ((4 + (b) * 2 + (h)) * HTB)
#define PG8_STAGE(bufoff, gbase, voff) do { _Pragma("unroll") for (int _i = 0; _i < 2; ++_i) \
        __builtin_amdgcn_global_load_lds((const unsigned*)((const char*)(gbase) + (voff)[_i]), (PG8_LAS unsigned*)(lds + (bufoff) + ldsw + _i * 8192), 16, 0, 0); } while (0)
#define PG8_LDA(dst, b, h) do { _Pragma("unroll") for (int m = 0; m < 4; ++m) _Pragma("unroll") for (int k = 0; k < 2; ++k) dst[m][k] = *(const PG8_LAS bf16x8*)(lds + PG8_SA(b, h) + aoff + m * 2048 + k * 1024); } while (0)
#define PG8_LDB(dst, b, h) do { _Pragma("unroll") for (int n = 0; n < 2; ++n) _Pragma("unroll") for (int k = 0; k < 2; ++k) dst[n][k] = *(const PG8_LAS bf16x8*)(lds + PG8_SB(b, h) + boff + n * 2048 + k * 1024); } while (0)
#define PG8_MMA(ai, bj, At, Bt) do { __builtin_amdgcn_s_setprio(1); _Pragma("unroll") for (int m = 0; m < 4; ++m) _Pragma("unroll") for (int n = 0; n < 2; ++n) _Pragma("unroll") for (int k = 0; k < 2; ++k) \
        acc[ai][bj][m][n] = __builtin_amdgcn_mfma_f32_16x16x32_bf16(Bt[n][k], At[m][k], acc[ai][bj][m][n], 0, 0, 0); __builtin_amdgcn_s_setprio(0); } while (0)
#define PG8_WAIT_V(n) asm volatile("s_waitcnt vmcnt(" #n ")" ::: "memory")
#define PG8_WAIT_L(n) asm volatile("s_waitcnt lgkmcnt(" #n ")" ::: "memory")
#define PG8_BAR __builtin_amdgcn_s_barrier()
#define PG8_SCHED __builtin_amdgcn_sched_barrier(0)
    Unit cur, nxt; int ui = 0;
    if (!S.next(0, cur)) return;
    f32x4 acc[2][2][4][2];
#pragma unroll
    for (int a = 0; a < 2; ++a)
#pragma unroll
        for (int b = 0; b < 2; ++b)
#pragma unroll
            for (int m = 0; m < 4; ++m)
#pragma unroll
                for (int n = 0; n < 2; ++n) acc[a][b][m][n] = (f32x4){0.f, 0.f, 0.f, 0.f};
    bf16x8 At[4][2], B0[2][2], B1[2][2];
    const char* cA = (const char*)g.A + (size_t)cur.pm * tstepA; const char* cB = (const char*)g.Bt + (size_t)cur.pn * tstep;
    S.a_ready(cur);
    if constexpr (SP2) {
        PG8_STAGE(PG8_SB(0, 0), cB, voffB); PG8_STAGE(PG8_SB(0, 1), cB + hstep, voffB); PG8_STAGE(PG8_SA(0, 0), cA, voffA); PG8_STAGE(PG8_SA(0, 1), cA + hstepA, voffA);
        if (wr == 1) PG8_BAR;
        PG8_WAIT_V(2); PG8_BAR;
        PG8_STAGE(PG8_SB(1, 0), cB + kstep, voffB); PG8_STAGE(PG8_SA(1, 0), cA + ks1, voffA); PG8_STAGE(PG8_SB(1, 1), cB + hstep + kstep, voffB);
        PG8_WAIT_V(6); PG8_BAR;
    } else {
        PG8_STAGE(PG8_SB(0, 0), cB, voffB); PG8_STAGE(PG8_SA(0, 0), cA, voffA); PG8_STAGE(PG8_SB(0, 1), cB + hstep, voffB); PG8_STAGE(PG8_SA(0, 1), cA + hstepA, voffA);
        if (wr == 1) PG8_BAR;
        PG8_WAIT_V(4); PG8_BAR;
        PG8_STAGE(PG8_SB(1, 0), cB + kstep, voffB); PG8_STAGE(PG8_SA(1, 0), cA + ks1, voffA); PG8_STAGE(PG8_SB(1, 1), cB + hstep + kstep, voffB);
        PG8_WAIT_V(6); PG8_BAR;
    }
    for (;;) {
        const bool has_next = S.next(ui + 1, nxt);
        const char* nA = has_next ? (const char*)g.A + (size_t)nxt.pm * tstepA : cA; const char* nB = has_next ? (const char*)g.Bt + (size_t)nxt.pn * tstep : cB;
        for (int t = 0; t < nt; t += 2) {
            const bool last = (t == nt - 2);
            const char* a1 = cA + (size_t)(t >> 1) * ks2 + ks1;
            const char* a2 = last ? nA : cA + (size_t)((t >> 1) + 1) * ks2; const char* b2 = last ? nB : cB + (size_t)(t + 2) * kstep;
            const char* a3 = a2 + ks1; const char* b3 = b2 + kstep;
            if (last && has_next) S.a_ready(nxt);
            if constexpr (SP2) {
            PG8_LDB(B0, 0, 0); PG8_LDB(B1, 0, 1); PG8_SCHED; PG8_LDA(At, 0, 0); PG8_STAGE(PG8_SA(1, 1), a1 + hstepA, voffA);
            PG8_WAIT_V(8); PG8_WAIT_L(0); PG8_BAR; PG8_MMA(0, 0, At, B0); PG8_MMA(0, 1, At, B1); PG8_BAR; PG8_SCHED;
            PG8_LDA(At, 0, 1); PG8_STAGE(PG8_SB(0, 0), b2, voffB); PG8_STAGE(PG8_SB(0, 1), b2 + hstep, voffB); PG8_STAGE(PG8_SA(0, 0), a2, voffA);
            PG8_WAIT_V(8); PG8_WAIT_L(0); PG8_BAR; PG8_MMA(1, 0, At, B0); PG8_MMA(1, 1, At, B1); PG8_BAR; PG8_SCHED;
            PG8_LDB(B0, 1, 0); PG8_LDB(B1, 1, 1); PG8_SCHED; PG8_LDA(At, 1, 0); PG8_STAGE(PG8_SA(0, 1), a2 + hstepA, voffA);
            PG8_WAIT_V(8); PG8_WAIT_L(0); PG8_BAR; PG8_MMA(0, 0, At, B0); PG8_MMA(0, 1, At, B1); PG8_BAR; PG8_SCHED;
            PG8_LDA(At, 1, 1); PG8_STAGE(PG8_SB(1, 0), b3, voffB); PG8_STAGE(PG8_SB(1, 1), b3 + hstep, voffB); PG8_STAGE(PG8_SA(1, 0), a3, voffA);
            PG8_WAIT_V(8); PG8_WAIT_L(0); PG8_BAR; PG8_MMA(1, 0, At, B0); PG8_MMA(1, 1, At, B1); PG8_BAR; PG8_SCHED;
            } else {
            PG8_LDB(B0, 0, 0); PG8_SCHED; PG8_LDA(At, 0, 0); PG8_STAGE(PG8_SA(1, 1), a1 + hstepA, voffA);
            PG8_WAIT_L(8); PG8_BAR; PG8_WAIT_L(0); PG8_MMA(0, 0, At, B0); PG8_BAR; PG8_SCHED;
            PG8_LDB(B1, 0, 1); PG8_STAGE(PG8_SB(0, 0), b2, voffB);
            PG8_BAR; PG8_WAIT_L(0); PG8_MMA(0, 1, At, B1); PG8_BAR;
            PG8_LDA(At, 0, 1); PG8_STAGE(PG8_SA(0, 0), a2, voffA);
            PG8_BAR; PG8_WAIT_L(0); PG8_MMA(1, 0, At, B0); PG8_BAR; PG8_SCHED;
            PG8_STAGE(PG8_SB(0, 1), b2 + hstep, voffB);
            PG8_WAIT_V(6); PG8_BAR; PG8_MMA(1, 1, At, B1); PG8_BAR;
            PG8_LDB(B0, 1, 0); PG8_SCHED; PG8_LDA(At, 1, 0); PG8_STAGE(PG8_SA(0, 1), a2 + hstepA, voffA);
            PG8_WAIT_L(8); PG8_BAR; PG8_WAIT_L(0); PG8_MMA(0, 0, At, B0); PG8_BAR; PG8_SCHED;
            PG8_LDB(B1, 1, 1); PG8_STAGE(PG8_SB(1, 0), b3, voffB);
            PG8_BAR; PG8_WAIT_L(0); PG8_MMA(0, 1, At, B1); PG8_BAR;
            PG8_LDA(At, 1, 1); PG8_STAGE(PG8_SA(1, 0), a3, voffA);
            PG8_BAR; PG8_WAIT_L(0); PG8_MMA(1, 0, At, B0); PG8_BAR; PG8_SCHED;
            PG8_STAGE(PG8_SB(1, 1), b3 + hstep, voffB);
            PG8_WAIT_V(6); PG8_BAR; PG8_MMA(1, 1, At, B1); PG8_BAR;
            }
        }
        if constexpr (ALIGN_EPI) { if (wr == 0) PG8_BAR; }
        if constexpr (!Epi::AFTER_DRAIN) { E(acc, cur, wr, wc, fr, fq); S.done(cur); }
        if (!has_next) break;
#pragma unroll
        for (int a = 0; a < 2; ++a)
#pragma unroll
            for (int b = 0; b < 2; ++b)
#pragma unroll
                for (int m = 0; m < 4; ++m)
#pragma unroll
                    for (int n = 0; n < 2; ++n) acc[a][b][m][n] = (f32x4){0.f, 0.f, 0.f, 0.f};
        cur = nxt; cA = nA; cB = nB; ++ui;
        if constexpr (ALIGN_EPI) { if (wr == 1) PG8_BAR; }
    }
    PG8_WAIT_V(0);
    if constexpr (!ALIGN_EPI) { if (wr == 0) PG8_BAR; }
    PG8_BAR;
    if constexpr (Epi::AFTER_DRAIN) { E.fused(acc, cur, wr, wc, fr, fq, lds, wid, lane); S.done(cur); }
#undef PG8_SA
#undef PG8_SB
#undef PG8_STAGE
#undef PG8_LDA
#undef PG8_LDB
#undef PG8_MMA
#undef PG8_WAIT_V
#undef PG8_WAIT_L
#undef PG8_BAR
#undef PG8_SCHED
}
}
#define LAS __attribute__((address_space(3)))
#define XB_TMO      128
#define XB_XCNT(j)  (256  + 64 * (j))
#define XB_XSUB(j)  (1280 + 64 * (j))
#define XB_XGEN(j)  (2304 + 64 * (j))
#define XB_TOP      3328
#define XB_TOPGEN   3392
#define XCD_BAR_WORDS 3456
#define XB_SPIN_CAP (1u << 18)

__device__ __forceinline__ unsigned xb_ld(unsigned* p)              { return __hip_atomic_load(p, __ATOMIC_RELAXED, __HIP_MEMORY_SCOPE_AGENT); }
__device__ __forceinline__ unsigned xb_add(unsigned* p, unsigned v) { return __hip_atomic_fetch_add(p, v, __ATOMIC_RELAXED, __HIP_MEMORY_SCOPE_AGENT); }
__device__ __forceinline__ unsigned xb_xcc_id() { return (unsigned)__builtin_amdgcn_s_getreg((3 << 11) | 20) & 0xFu; }
#define XB_SPIN(cond, bar) do { unsigned _sp = 0; while (cond) { __builtin_amdgcn_s_sleep(1); \
    if ((++_sp & 255u) == 0u) { if (xb_ld(&(bar)[XB_TMO])) break; if (_sp > XB_SPIN_CAP) { atomicAdd(&(bar)[XB_TMO], 1u); break; } } } } while (0)

struct XcdBarrier {
    unsigned* bar; unsigned x;
    volatile LAS unsigned* st;
};

__device__ __forceinline__ XcdBarrier xcd_barrier_post(unsigned* bar, volatile LAS unsigned* st) {
    XcdBarrier b; b.bar = bar; b.x = xb_xcc_id(); b.st = st;
    if (threadIdx.x == 0) (void)xb_add(&bar[XB_XCNT(b.x)], 1u);
    return b;
}
__device__ __forceinline__ void xcd_barrier_complete(unsigned* bar, unsigned x, unsigned& nloc, unsigned& nx) {
    const unsigned G = gridDim.x * gridDim.y * gridDim.z;
    unsigned sum, cnt, mine, sp = 0u;
    for (;;) {
        sum = 0u; cnt = 0u; mine = 0u;
#pragma unroll
        for (unsigned j = 0; j < 16; ++j) { const unsigned c = xb_ld(&bar[XB_XCNT(j)]); sum += c; cnt += (c > 0u) ? 1u : 0u; mine = (j == x) ? c : mine; }
        if (sum == G) break;
        __builtin_amdgcn_s_sleep(1);
        if ((++sp & 255u) == 0u) { if (xb_ld(&bar[XB_TMO])) break; if (sp > XB_SPIN_CAP) { atomicAdd(&bar[XB_TMO], 1u); break; } }
    }
    nloc = mine > 0u ? mine : 1u; nx = cnt > 0u ? cnt : 1u;
}

__device__ __forceinline__ void xcd_barrier(const XcdBarrier& b) {
    asm volatile("s_waitcnt vmcnt(0)" ::: "memory");
    __syncthreads();
    if (threadIdx.x == 0) {
        unsigned* bar = b.bar;
        __builtin_amdgcn_s_waitcnt(0);
        unsigned nloc = b.st[0], nx = b.st[1];
        if (nloc == 0u) { xcd_barrier_complete(bar, b.x, nloc, nx); b.st[0] = nloc; b.st[1] = nx; }
        const unsigned old = xb_add(&bar[XB_XSUB(b.x)], 1u);
        const unsigned gen = old / nloc;
        if (old + 1u == (gen + 1u) * nloc) {
            __builtin_amdgcn_fence(__ATOMIC_RELEASE, "agent");
            asm volatile("s_waitcnt vmcnt(0)" ::: "memory");
            const unsigned og = xb_add(&bar[XB_TOP], 1u);
            const unsigned tg = og / nx;
            if (og + 1u == (tg + 1u) * nx) xb_add(&bar[XB_TOPGEN], 1u);
            else XB_SPIN(xb_ld(&bar[XB_TOPGEN]) == tg, bar);
            __builtin_amdgcn_fence(__ATOMIC_ACQUIRE, "agent");
            xb_add(&bar[XB_XGEN(b.x)], 1u);
            asm volatile("s_waitcnt vmcnt(0)" ::: "memory");
        } else {
            XB_SPIN(xb_ld(&bar[XB_XGEN(b.x)]) == gen, bar);
            __builtin_amdgcn_fence(__ATOMIC_ACQUIRE, "agent");
            asm volatile("s_waitcnt vmcnt(0)" ::: "memory");
        }
    }
    __syncthreads();
}

#define GAS __attribute__((address_space(1)))
typedef unsigned short bf16;
typedef unsigned v4u __attribute__((ext_vector_type(4)));
typedef unsigned v2u __attribute__((ext_vector_type(2)));
typedef float f32x4 __attribute__((ext_vector_type(4)));
typedef float f32x2 __attribute__((ext_vector_type(2)));
typedef float f32x16 __attribute__((ext_vector_type(16)));
typedef short bf16x8 __attribute__((ext_vector_type(8)));
typedef short s16x4 __attribute__((ext_vector_type(4)));
typedef __bf16 bf16x2_t __attribute__((ext_vector_type(2)));
#define LDS_WAIT() asm volatile("s_waitcnt lgkmcnt(0)" ::: "memory")
#define VM_WAIT() asm volatile("s_waitcnt vmcnt(0)" ::: "memory")

__device__ __forceinline__ unsigned pk2(float lo, float hi) { f32x2 v = {lo, hi}; bf16x2_t b = __builtin_convertvector(v, bf16x2_t); return __builtin_bit_cast(unsigned, b); }
__device__ __forceinline__ float bf_lo(unsigned u) { return __uint_as_float(u << 16); }
__device__ __forceinline__ float bf_hi(unsigned u) { return __uint_as_float(u & 0xffff0000u); }
__device__ __forceinline__ float bf1(bf16 h) { return __uint_as_float(((unsigned)h) << 16); }
__device__ __forceinline__ float wave_sum(float v) {
#pragma unroll
    for (int o = 1; o < 64; o <<= 1) v += __shfl_xor(v, o);
    return v;
}
__device__ __forceinline__ float wave_max(float v) {
#pragma unroll
    for (int o = 1; o < 64; o <<= 1) v = fmaxf(v, __shfl_xor(v, o));
    return v;
}
__device__ __forceinline__ float swap_max(float m) { auto rr = __builtin_amdgcn_permlane32_swap(__float_as_uint(m), __float_as_uint(m), false, false); return fmaxf(__uint_as_float(rr[0]), __uint_as_float(rr[1])); }
__device__ __forceinline__ float swap_sum(float m) { auto rr = __builtin_amdgcn_permlane32_swap(__float_as_uint(m), __float_as_uint(m), false, false); return __uint_as_float(rr[0]) + __uint_as_float(rr[1]); }
__device__ __forceinline__ float fast_exp2(float x) { return __builtin_amdgcn_exp2f(x); }
__device__ __forceinline__ float quad_sum(float x) {
    float y = x + __int_as_float(__builtin_amdgcn_update_dpp(0, __float_as_int(x), 0xB1, 0xF, 0xF, true));
    return y + __int_as_float(__builtin_amdgcn_update_dpp(0, __float_as_int(y), 0x4E, 0xF, 0xF, true));
}
__device__ __forceinline__ float row16_sum(float x) {
    float y = quad_sum(x);
    y += __int_as_float(__builtin_amdgcn_update_dpp(0, __float_as_int(y), 0x124, 0xF, 0xF, true));
    return y + __int_as_float(__builtin_amdgcn_update_dpp(0, __float_as_int(y), 0x128, 0xF, 0xF, true));
}

constexpr int DM = 1024, SEQ = 8192, MP = 2 * SEQ, NS = 32, FF = 4096;
constexpr float EPS = 1e-6f;
constexpr float C2 = 0.125f * 1.4426950408889634f;
constexpr int NKVQG = 2816, NQG1 = 1280;
constexpr int ACMP_ROWS = 69632;
constexpr size_t O_Y = 0, O_YS = 16777216, O_CMP = 16809984, O_SEL = 25198592, O_WIN = 33587200, O_CMPS = 34111488, O_SELS = 34127872, O_WINS = 34144256, O_AV = 42532864, O_END = 42598400;

constexpr size_t MiB = 1u << 20;
constexpr size_t WS_CTL = 0, CTL_ZERO_BYTES = 1 * MiB;
constexpr size_t WS_WUV = 2 * MiB, WS_WAO = 10 * MiB, WS_WSB = 14 * MiB, WS_WKVQG = 15 * MiB, WS_WQG1 = 21 * MiB, WS_WBO = 24 * MiB, WS_WUP = 28 * MiB, WS_WDN = 60 * MiB, WS_WC1 = 92 * MiB, WS_WC2 = 94 * MiB;
constexpr size_t WS_BIAS1 = 94 * MiB + 512 * 1024;
constexpr size_t WS_ROWSS2 = 194 * MiB;
constexpr size_t WS_XN = 96 * MiB, WS_U = 128 * MiB, WS_V = 160 * MiB, WS_ROWSS = 192 * MiB, WS_H1 = 200 * MiB, WS_KSEL = 328 * MiB, WS_KWIN = 344 * MiB, WS_Q = 360 * MiB, WS_GATES = 392 * MiB, WS_OATT = 396 * MiB;
constexpr size_t WS_ACMP = 428 * MiB, WS_TB = 700 * MiB, WS_TB_STRIDE = 70 * MiB, WS_KC = 840 * MiB, WS_VC = 850 * MiB;
constexpr size_t WS_SMP = 860 * MiB, SMP_SLOT = 256 * 1024;
constexpr size_t WS_XNS = WS_SMP, WS_USU = WS_SMP + 1 * SMP_SLOT, WS_VSF = WS_SMP + 2 * SMP_SLOT, WS_USS = WS_SMP + 3 * SMP_SLOT, WS_H1S = WS_SMP + 4 * SMP_SLOT, WS_QS = WS_SMP + 5 * SMP_SLOT, WS_GS = WS_SMP + 6 * SMP_SLOT, WS_OS = WS_SMP + 7 * SMP_SLOT, WS_HS = WS_SMP + 8 * SMP_SLOT;
constexpr size_t WS_HB = 864 * MiB;
constexpr size_t WS_WC1F = 932 * MiB;
constexpr size_t WS_END = 936 * MiB;
constexpr int CW_BAR = 4096;

constexpr int RING_BYTES = 131072, LDS_BYTES = 147456, LDSCTL_OFF = LDS_BYTES - 2048, MISC_OFF = LDSCTL_OFF + 320;
constexpr int NWAVES = 8;

struct Args { const void* in[28]; float* out; unsigned char* ws; int ph_lo, ph_hi, use_bar, pad; };

__device__ __forceinline__ void rows_rstd(const float* rs, int row0, int fq, float (&r)[2][4]) {
    pg8::f32x4 p[2][4];
#pragma unroll
    for (int ai = 0; ai < 2; ++ai)
#pragma unroll
        for (int m = 0; m < 4; ++m) p[ai][m] = *(const pg8::f32x4*)(rs + (size_t)(row0 + ai * 128 + m * 16) * 16 + 4 * fq);
#pragma unroll
    for (int ai = 0; ai < 2; ++ai)
#pragma unroll
        for (int m = 0; m < 4; ++m) { float t = (p[ai][m][0] + p[ai][m][1]) + (p[ai][m][2] + p[ai][m][3]); t += __shfl_xor(t, 16); t += __shfl_xor(t, 32); r[ai][m] = rsqrtf(t * (1.f / DM) + EPS); }
}
constexpr int RSTD_CACHE_OFF = RING_BYTES + 4096;
__device__ __forceinline__ void rows_rstd_cached(const float* rs, int pm, int& last_pm, int row0, int wr, int wc, int fr, int fq, float (&r)[2][4]) {
    extern __shared__ __attribute__((aligned(16))) unsigned char lds_dyn_base[];
    LAS float* rc = (LAS float*)((LAS unsigned char*)lds_dyn_base + RSTD_CACHE_OFF) + wr * 64 + fr;
    if (pm != last_pm) { rows_rstd(rs, row0, fq, r); last_pm = pm;
        if (wc == 0 && fq == 0) {
#pragma unroll
            for (int ai = 0; ai < 2; ++ai)
#pragma unroll
                for (int m = 0; m < 4; ++m) rc[ai * 128 + m * 16] = r[ai][m]; } }
    else {
#pragma unroll
        for (int ai = 0; ai < 2; ++ai)
#pragma unroll
            for (int m = 0; m < 4; ++m) r[ai][m] = rc[ai * 128 + m * 16]; }
}
struct EpiUV {
    static constexpr bool PERM = true, AFTER_DRAIN = false;
    bf16* U; bf16* V; float* rowss; const float* rs_in; mutable int last_pm = -1;
    __device__ __forceinline__ void operator()(const pg8::f32x4 (&acc)[2][2][4][2], const pg8::Unit& u, int wr, int wc, int fr_, int fq_) const {
        int fr = fr_, fq = fq_; asm volatile("" : "+v"(fr), "+v"(fq));
        const bool isv = u.pn >= 4; bf16* base = isv ? V : U;
        const int row0 = u.pm * 256 + wr * 64 + fr, col0 = (u.pn & 3) * 256 + wc * 32 + 8 * fq;
        float rs8[2][4]; rows_rstd_cached(rs_in, u.pm, last_pm, row0, wr, wc, fr, fq, rs8);
#pragma unroll
        for (int ai = 0; ai < 2; ++ai)
#pragma unroll
            for (int m = 0; m < 4; ++m) { const int row = row0 + ai * 128 + m * 16; float ss = 0.f; const float rstd = rs8[ai][m];
#pragma unroll
                for (int bj = 0; bj < 2; ++bj) { const pg8::f32x4 v0 = acc[ai][bj][m][0] * rstd, v1 = acc[ai][bj][m][1] * rstd;
                    ss += (v0[0] * v0[0] + v0[1] * v0[1]) + (v0[2] * v0[2] + v0[3] * v0[3]) + (v1[0] * v1[0] + v1[1] * v1[1]) + (v1[2] * v1[2] + v1[3] * v1[3]);
                    v4u w; w.x = pk2(v0[0], v0[1]); w.y = pk2(v0[2], v0[3]); w.z = pk2(v1[0], v1[1]); w.w = pk2(v1[2], v1[3]);
                    *(v4u*)(base + (size_t)row * DM + col0 + bj * 128) = w; }
                if (isv) { ss += __shfl_xor(ss, 16); ss += __shfl_xor(ss, 32); if (fq == 0) rowss[(size_t)row * 16 + (u.pn - 4) * 4 + wc] = ss; } }
    }
};
struct EpiSqRelu {
    static constexpr bool PERM = true, AFTER_DRAIN = false;
    bf16* O; int ldc; const float* rs_in; mutable int last_pm = -1;
    __device__ __forceinline__ void operator()(const pg8::f32x4 (&acc)[2][2][4][2], const pg8::Unit& u, int wr, int wc, int fr_, int fq_) const {
        int fr = fr_, fq = fq_; asm volatile("" : "+v"(fr), "+v"(fq));
        const int row0 = u.pm * 256 + wr * 64 + fr, col0 = u.pn * 256 + wc * 32 + 8 * fq;
        float rs8[2][4]; rows_rstd_cached(rs_in, u.pm, last_pm, row0, wr, wc, fr, fq, rs8);
#pragma unroll
        for (int ai = 0; ai < 2; ++ai)
#pragma unroll
            for (int m = 0; m < 4; ++m) { const int row = row0 + ai * 128 + m * 16; const float rstd = rs8[ai][m];
#pragma unroll
                for (int bj = 0; bj < 2; ++bj) { pg8::f32x4 v0 = acc[ai][bj][m][0], v1 = acc[ai][bj][m][1];
#pragma unroll
                    for (int e = 0; e < 4; ++e) { const float a = fmaxf(v0[e] * rstd, 0.f), b = fmaxf(v1[e] * rstd, 0.f); v0[e] = a * a; v1[e] = b * b; }
                    v4u w; w.x = pk2(v0[0], v0[1]); w.y = pk2(v0[2], v0[3]); w.z = pk2(v1[0], v1[1]); w.w = pk2(v1[2], v1[3]);
                    *(v4u*)(O + (size_t)row * ldc + col0 + bj * 128) = w; } }
    }
};
struct EpiStore {
    static constexpr bool PERM = true, AFTER_DRAIN = false;
    bf16* O; int ldc;
    __device__ __forceinline__ void operator()(const pg8::f32x4 (&acc)[2][2][4][2], const pg8::Unit& u, int wr, int wc, int fr_, int fq_) const {
        int fr = fr_, fq = fq_; asm volatile("" : "+v"(fr), "+v"(fq));
        const int row0 = u.pm * 256 + wr * 64 + fr, col0 = u.pn * 256 + wc * 32 + 8 * fq;
#pragma unroll
        for (int ai = 0; ai < 2; ++ai)
#pragma unroll
            for (int m = 0; m < 4; ++m) { const int row = row0 + ai * 128 + m * 16;
#pragma unroll
                for (int bj = 0; bj < 2; ++bj) { const pg8::f32x4 v0 = acc[ai][bj][m][0], v1 = acc[ai][bj][m][1];
                    v4u w; w.x = pk2(v0[0], v0[1]); w.y = pk2(v0[2], v0[3]); w.z = pk2(v1[0], v1[1]); w.w = pk2(v1[2], v1[3]);
                    *(v4u*)(O + (size_t)row * ldc + col0 + bj * 128) = w; } }
    }
};
struct TBOrder {
    int G, c;
    __device__ __forceinline__ bool next(int i, pg8::Unit& u) const {
        if (G != 256) { const int L = i * G + c; if (L >= 1088) return false; const int kv = L >= 544 ? 1 : 0, r = L - 544 * kv; u.pm = 272 * kv + (r >> 1); u.pn = 2 * kv + (r & 1); return true; }
        const int x = c & 7, y = c >> 3, pmidx = i * 128 + (y >> 1) * 8 + x; if (pmidx >= 544) return false;
        const int kv = pmidx >= 272 ? 1 : 0; u.pm = pmidx; u.pn = 2 * kv + (y & 1); return true; }
    __device__ __forceinline__ void a_ready(const pg8::Unit&) const {}
    __device__ __forceinline__ void done(const pg8::Unit&) const {}
};
__device__ __forceinline__ float gelu_tanh(float x) { const float y = 0.7978845608028654f * (x + 0.044715f * x * x * x); return x / (1.f + __expf(-2.f * y)); }
__device__ __forceinline__ void combine16_fused(const bf16* __restrict__ HBk, const bf16* __restrict__ w2t, bf16* __restrict__ outp, int un, int lane) {
    const int m = un * 16 + (lane & 15), ko = 8 * (lane >> 4); const bool dead = ((m >> 2) & 511) == 511;
    f32x4 acc[4];
#pragma unroll
    for (int nt = 0; nt < 4; ++nt) acc[nt] = (f32x4){0.f, 0.f, 0.f, 0.f};
    v4u hva[8];
#pragma unroll
    for (int ks = 0; ks < 8; ++ks) hva[ks] = *(const v4u*)(HBk + (size_t)m * 256 + 32 * ks + ko);
#pragma unroll
    for (int ks = 0; ks < 8; ++ks) { const int k = 32 * ks + ko; const bf16x8 hf = __builtin_bit_cast(bf16x8, hva[ks]);
#pragma unroll
        for (int nt = 0; nt < 4; ++nt) { const bf16x8 wf = *(const bf16x8*)(w2t + (size_t)(16 * nt + (lane & 15)) * 256 + k);
            acc[nt] = __builtin_amdgcn_mfma_f32_16x16x32_bf16(wf, hf, acc[nt], 0, 0, 0); } }
#pragma unroll
    for (int nt = 0; nt < 4; ++nt) { v2u o; o.x = dead ? 0u : pk2(acc[nt][0], acc[nt][1]); o.y = dead ? 0u : pk2(acc[nt][2], acc[nt][3]);
        *(v2u*)(outp + (size_t)m * 64 + 16 * nt + 4 * (lane >> 4)) = o; }
}
__device__ __forceinline__ void combine16_tb(const bf16* __restrict__ TB, const float* __restrict__ bias1, const bf16* __restrict__ w2t, bf16* __restrict__ outp, int un, int lane) {
    const int m = un * 16 + (lane & 15), ko = 8 * (lane >> 4); const bool dead = ((m >> 2) & 511) == 511;
    f32x4 acc[4];
#pragma unroll
    for (int nt = 0; nt < 4; ++nt) acc[nt] = (f32x4){0.f, 0.f, 0.f, 0.f};
    v4u tva[8], bva[8];
#pragma unroll
    for (int ks = 0; ks < 8; ++ks) { const int k = 32 * ks + ko; tva[ks] = (v4u){0u, 0u, 0u, 0u}; bva[ks] = (v4u){0u, 0u, 0u, 0u};
        if (!dead) { tva[ks] = *(const v4u*)(TB + (size_t)m * 512 + k); bva[ks] = *(const v4u*)(TB + (size_t)(m + 4) * 512 + 256 + k); } }
#pragma unroll
    for (int ks = 0; ks < 8; ++ks) { const int k = 32 * ks + ko; const v4u tv = tva[ks], bv = bva[ks];
        const f32x4 b0 = *(const f32x4*)(bias1 + k), b1 = *(const f32x4*)(bias1 + k + 4);
        v4u hp;
        hp.x = pk2(gelu_tanh(bf_lo(tv.x) + bf_lo(bv.x) + b0.x), gelu_tanh(bf_hi(tv.x) + bf_hi(bv.x) + b0.y));
        hp.y = pk2(gelu_tanh(bf_lo(tv.y) + bf_lo(bv.y) + b0.z), gelu_tanh(bf_hi(tv.y) + bf_hi(bv.y) + b0.w));
        hp.z = pk2(gelu_tanh(bf_lo(tv.z) + bf_lo(bv.z) + b1.x), gelu_tanh(bf_hi(tv.z) + bf_hi(bv.z) + b1.y));
        hp.w = pk2(gelu_tanh(bf_lo(tv.w) + bf_lo(bv.w) + b1.z), gelu_tanh(bf_hi(tv.w) + bf_hi(bv.w) + b1.w));
        const bf16x8 hf = __builtin_bit_cast(bf16x8, hp);
#pragma unroll
        for (int nt = 0; nt < 4; ++nt) { const bf16x8 wf = *(const bf16x8*)(w2t + (size_t)(16 * nt + (lane & 15)) * 256 + k);
            acc[nt] = __builtin_amdgcn_mfma_f32_16x16x32_bf16(wf, hf, acc[nt], 0, 0, 0); } }
#pragma unroll
    for (int nt = 0; nt < 4; ++nt) { v2u o; o.x = dead ? 0u : pk2(acc[nt][0], acc[nt][1]); o.y = dead ? 0u : pk2(acc[nt][2], acc[nt][3]);
        *(v2u*)(outp + (size_t)m * 64 + 16 * nt + 4 * (lane >> 4)) = o; }
}
struct TBFOrder {
    int G, c; const bf16* HB; const bf16* W2; bf16* KC; bf16* VC;
    __device__ __forceinline__ bool next(int i, pg8::Unit& u) const { const int L = i * G + c; if (L >= 512) return false; const int kv = L >> 8, idx = L & 255, rt = idx < 240 ? idx : idx + 16; u.pm = 272 * kv + rt; u.pn = kv; return true; }
    __device__ __forceinline__ void a_ready(const pg8::Unit&) const {}
    __device__ __forceinline__ void done(const pg8::Unit& u) const {
        asm volatile("s_waitcnt vmcnt(0)" ::: "memory");
        __syncthreads();
        int tid_l = threadIdx.x; asm volatile("" : "+v"(tid_l)); const int lane = tid_l & 63, w = __builtin_amdgcn_readfirstlane(tid_l >> 6);
        const int kv = u.pn, un0 = (u.pm - 272 * kv) * 16 + 2 * w;
        const bf16* HBk = HB + (size_t)kv * ACMP_ROWS * 256; const bf16* w2t = W2 + (size_t)kv * 64 * 256; bf16* outp = kv ? VC : KC;
        combine16_fused(HBk, w2t, outp, un0, lane); combine16_fused(HBk, w2t, outp, un0 + 1, lane);
    }
};
struct TBEarlyOrder {
    int G, c;
    __device__ __forceinline__ bool next(int i, pg8::Unit& u) const { int e;
        if (G == 256) { if (i != 0 || c < 192) return false; e = c - 192; } else { e = i * G + c; if (e >= 64) return false; }
        const int x = e & 7, y = e >> 3, pidx = (y >> 1) * 8 + x, kv = pidx >> 4; u.pm = 272 * kv + 240 + (pidx & 15); u.pn = 2 * kv + (y & 1); return true; }
    __device__ __forceinline__ void a_ready(const pg8::Unit&) const {}
    __device__ __forceinline__ void done(const pg8::Unit&) const {}
};
struct EpiH {
    static constexpr bool PERM = true, AFTER_DRAIN = false;
    bf16* HB; const float* bias1;
    __device__ __forceinline__ void operator()(const pg8::f32x4 (&acc)[2][2][4][2], const pg8::Unit& u, int wr, int wc, int fr_, int fq_) const {
        int fr = fr_, fq = fq_; asm volatile("" : "+v"(fr), "+v"(fq));
        const int row0 = u.pm * 256 + wr * 64 + fr, col0 = wc * 32 + 8 * fq; const float* bp = bias1 + u.pn * 256 + col0;
#pragma unroll
        for (int bj = 0; bj < 2; ++bj) { const pg8::f32x4 b0 = *(const pg8::f32x4*)(bp + bj * 128), b1 = *(const pg8::f32x4*)(bp + bj * 128 + 4);
#pragma unroll
            for (int ai = 0; ai < 2; ++ai)
#pragma unroll
                for (int m = 0; m < 4; ++m) { const int row = row0 + ai * 128 + m * 16; const pg8::f32x4 v0 = acc[ai][bj][m][0] + b0, v1 = acc[ai][bj][m][1] + b1;
                    v4u w; w.x = pk2(gelu_tanh(v0[0]), gelu_tanh(v0[1])); w.y = pk2(gelu_tanh(v0[2]), gelu_tanh(v0[3])); w.z = pk2(gelu_tanh(v1[0]), gelu_tanh(v1[1])); w.w = pk2(gelu_tanh(v1[2]), gelu_tanh(v1[3]));
                    *(v4u*)(HB + (size_t)row * 256 + col0 + bj * 128) = w; } }
    }
};
struct EpiTB {
    static constexpr bool PERM = true, AFTER_DRAIN = false;
    bf16* TB;
    __device__ __forceinline__ void operator()(const pg8::f32x4 (&acc)[2][2][4][2], const pg8::Unit& u, int wr, int wc, int fr_, int fq_) const {
        int fr = fr_, fq = fq_; asm volatile("" : "+v"(fr), "+v"(fq));
        const int kv = u.pn >> 1; bf16* O = TB + (size_t)kv * (WS_TB_STRIDE / 2);
        const int row0 = (u.pm - 272 * kv) * 256 + wr * 64 + fr, col0 = (u.pn & 1) * 256 + wc * 32 + 8 * fq;
#pragma unroll
        for (int ai = 0; ai < 2; ++ai)
#pragma unroll
            for (int m = 0; m < 4; ++m) { const int row = row0 + ai * 128 + m * 16;
#pragma unroll
                for (int bj = 0; bj < 2; ++bj) { const pg8::f32x4 v0 = acc[ai][bj][m][0], v1 = acc[ai][bj][m][1];
                    v4u w; w.x = pk2(v0[0], v0[1]); w.y = pk2(v0[2], v0[3]); w.z = pk2(v1[0], v1[1]); w.w = pk2(v1[2], v1[3]);
                    *(v4u*)(O + (size_t)row * 512 + col0 + bj * 128) = w; } }
    }
};
struct EpiResid {
    static constexpr bool PERM = true, AFTER_DRAIN = false;
    bf16* xb; float* rs_out;
    __device__ __forceinline__ void operator()(const pg8::f32x4 (&acc)[2][2][4][2], const pg8::Unit& u, int wr, int wc, int fr_, int fq_) const {
        int fr = fr_, fq = fq_; asm volatile("" : "+v"(fr), "+v"(fq));
        const int row0 = u.pm * 256 + wr * 64 + fr, col0 = u.pn * 256 + wc * 32 + 8 * fq;
#pragma unroll
        for (int ai = 0; ai < 2; ++ai) {
            v4u bx[4][2];
#pragma unroll
            for (int m = 0; m < 4; ++m)
#pragma unroll
                for (int bj = 0; bj < 2; ++bj) bx[m][bj] = *(const v4u*)(xb + (size_t)(row0 + ai * 128 + m * 16) * DM + col0 + bj * 128);
            asm volatile("" ::: "memory");
#pragma unroll
            for (int m = 0; m < 4; ++m) { const int row = row0 + ai * 128 + m * 16; float ss = 0.f;
#pragma unroll
                for (int bj = 0; bj < 2; ++bj) { const v4u b = bx[m][bj]; const pg8::f32x4 a0 = acc[ai][bj][m][0], a1 = acc[ai][bj][m][1];
                    const float x0 = bf_lo(b.x) + a0[0], x1 = bf_hi(b.x) + a0[1], x2 = bf_lo(b.y) + a0[2], x3 = bf_hi(b.y) + a0[3];
                    const float x4 = bf_lo(b.z) + a1[0], x5 = bf_hi(b.z) + a1[1], x6 = bf_lo(b.w) + a1[2], x7 = bf_hi(b.w) + a1[3];
                    ss += ((x0 * x0 + x1 * x1) + (x2 * x2 + x3 * x3)) + ((x4 * x4 + x5 * x5) + (x6 * x6 + x7 * x7));
                    v4u w; w.x = pk2(x0, x1); w.y = pk2(x2, x3); w.z = pk2(x4, x5); w.w = pk2(x6, x7);
                    *(v4u*)(xb + (size_t)row * DM + col0 + bj * 128) = w; }
                ss += __shfl_xor(ss, 16); ss += __shfl_xor(ss, 32); if (fq == 0) rs_out[(size_t)row * 16 + u.pn * 4 + wc] = ss; }
            asm volatile("" ::: "memory");
        }
    }
};
struct EpiKVQG {
    static constexpr bool PERM = false, AFTER_DRAIN = false;
    float* out; bf16* acmp; bf16* ksel; bf16* kwin; bf16* q; float* gates; const float* bg; int tile_off; const float* rs_in; mutable int last_pm = -1;
    __device__ __forceinline__ void operator()(const pg8::f32x4 (&acc)[2][2][4][2], const pg8::Unit& u, int wr, int wc, int fr_, int fq_) const {
        int fr = fr_, fq = fq_; asm volatile("" : "+v"(fr), "+v"(fq));
        const int kind = u.pn + tile_off;
        const int row0 = u.pm * 256 + wr * 64 + fr, cw = wc * 32 + 4 * fq;
        float rs8[2][4]; rows_rstd_cached(rs_in, u.pm, last_pm, row0, wr, wc, fr, fq, rs8);
#pragma unroll
        for (int ai = 0; ai < 2; ++ai)
#pragma unroll
            for (int m = 0; m < 4; ++m) { const int row = row0 + ai * 128 + m * 16, b = row >> 13, t = row & 8191; const float rstd = rs8[ai][m];
#pragma unroll
                for (int bj = 0; bj < 2; ++bj)
#pragma unroll
                    for (int n = 0; n < 2; ++n) { const int ct = cw + bj * 128 + n * 16; const pg8::f32x4 v = acc[ai][bj][m][n] * rstd;
                        if (kind < 2) {
                            *(pg8::f32x4*)(out + O_CMP + (size_t)row * 512 + kind * 256 + ct) = v;
                            bf16* dst = acmp + ((size_t)kind * ACMP_ROWS + 65536 + (size_t)((b * 512 + (t >> 4)) * 4 + (ct >> 6))) * 1024 + (t & 15) * 64 + (ct & 63);
                            v2u w; w.x = pk2(v[0], v[1]); w.y = pk2(v[2], v[3]); *(v2u*)dst = w;
                        } else if (kind < 4) {
                            *(pg8::f32x4*)(out + O_SEL + (size_t)row * 512 + (kind - 2) * 256 + ct) = v;
                            v2u w; w.x = pk2(v[0], v[1]); w.y = pk2(v[2], v[3]); *(v2u*)(ksel + (size_t)row * 512 + (kind - 2) * 256 + ct) = w;
                        } else if (kind < 6) {
                            if (t >= SEQ - 512) *(pg8::f32x4*)(out + O_WIN + (size_t)(b * 512 + t - (SEQ - 512)) * 512 + (kind - 4) * 256 + ct) = v;
                            v2u w; w.x = pk2(v[0], v[1]); w.y = pk2(v[2], v[3]); *(v2u*)(kwin + (size_t)row * 512 + (kind - 4) * 256 + ct) = w;
                        } else if (kind < 10) {
                            v2u w; w.x = pk2(v[0] * C2, v[1] * C2); w.y = pk2(v[2] * C2, v[3] * C2); *(v2u*)(q + (size_t)row * DM + (kind - 6) * 256 + ct) = w;
                        } else {
                            if (ct < 48) { pg8::f32x4 o;
#pragma unroll
                                for (int e = 0; e < 4; ++e) o[e] = 1.f / (1.f + __expf(-(v[e] + bg[ct + e])));
                                *(pg8::f32x4*)(gates + (size_t)row * 48 + ct) = o; }
                        } } }
    }
};

template <int NT, class Epi>
__device__ __forceinline__ void wave_gemm16(const bf16* __restrict__ A, const bf16* __restrict__ W, int M, int N, int gw, int NGW, int lane, const Epi& E) {
    const int ncg = N / (16 * NT), nun = (M >> 4) * ncg;
    for (int un = gw; un < nun; un += NGW) { const int rt = un / ncg, cg = un - rt * ncg;
        f32x4 acc[NT];
#pragma unroll
        for (int nt = 0; nt < NT; ++nt) acc[nt] = (f32x4){0.f, 0.f, 0.f, 0.f};
        const bf16* ap = A + (size_t)(rt * 16 + (lane & 15)) * 1024 + 8 * (lane >> 4);
        const bf16* wp = W + (size_t)(cg * NT * 16 + (lane & 15)) * 1024 + 8 * (lane >> 4);
#pragma unroll 4
        for (int k = 0; k < 1024; k += 32) { const bf16x8 a = *(const bf16x8*)(ap + k);
#pragma unroll
            for (int nt = 0; nt < NT; ++nt) { const bf16x8 w = *(const bf16x8*)(wp + (size_t)nt * 16 * 1024 + k); acc[nt] = __builtin_amdgcn_mfma_f32_16x16x32_bf16(w, a, acc[nt], 0, 0, 0); } }
#pragma unroll
        for (int nt = 0; nt < NT; ++nt) E(rt * 16 + (lane & 15), (cg * NT + nt) * 16 + 4 * (lane >> 4), acc[nt]);
    }
}
struct WgStoreBf16 { bf16* O; int ldc; __device__ __forceinline__ void operator()(int row, int col0, const f32x4& v) const { v2u w; w.x = pk2(v[0], v[1]); w.y = pk2(v[2], v[3]); *(v2u*)(O + (size_t)row * ldc + col0) = w; } };
struct WgGates { float* gates; const float* bg; const float* rs;
    __device__ __forceinline__ void operator()(int row, int col0, const f32x4& v) const {
        const f32x4* p = (const f32x4*)(rs + (size_t)row * 16); const f32x4 a = p[0], b = p[1], c = p[2], d = p[3];
        const float t = ((a[0] + a[1]) + (a[2] + a[3])) + ((b[0] + b[1]) + (b[2] + b[3])) + ((c[0] + c[1]) + (c[2] + c[3])) + ((d[0] + d[1]) + (d[2] + d[3]));
        const float rstd = rsqrtf(t * (1.f / DM) + EPS); f32x4 o;
#pragma unroll
        for (int e = 0; e < 4; ++e) o[e] = 1.f / (1.f + __expf(-(v[e] * rstd + bg[col0 + e])));
        *(f32x4*)(gates + (size_t)row * 48 + col0) = o; } };

template <class Epi>
__device__ __forceinline__ void skinny_gemm(LAS unsigned char* lds, const bf16* __restrict__ A, const bf16* __restrict__ Wt, int K, int N, const Epi& E) {
    int tid_l = threadIdx.x; asm volatile("" : "+v"(tid_l)); const int tid = tid_l, lane = tid & 63, wid = tid >> 6;
    LAS float* red = (LAS float*)lds;
    const int kper = K >> 3, kbeg = wid * kper;
    for (int u = blockIdx.x; u < (N >> 4); u += gridDim.x) {
        f32x4 acc0 = {0.f, 0.f, 0.f, 0.f}, acc1 = {0.f, 0.f, 0.f, 0.f};
        const bf16* wrow = Wt + (size_t)(u * 16 + (lane & 15)) * K + kbeg + 8 * (lane >> 4);
        const bf16* a0 = A + (size_t)(lane & 15) * K + kbeg + 8 * (lane >> 4);
        const bf16* a1 = a0 + (size_t)16 * K;
#pragma unroll 4
        for (int k = 0; k < kper; k += 32) {
            const bf16x8 b = *(const bf16x8*)(wrow + k), x0 = *(const bf16x8*)(a0 + k), x1 = *(const bf16x8*)(a1 + k);
            acc0 = __builtin_amdgcn_mfma_f32_16x16x32_bf16(x0, b, acc0, 0, 0, 0);
            acc1 = __builtin_amdgcn_mfma_f32_16x16x32_bf16(x1, b, acc1, 0, 0, 0);
        }
        *(LAS f32x4*)(red + ((wid * 2 + 0) * 64 + lane) * 4) = acc0;
        *(LAS f32x4*)(red + ((wid * 2 + 1) * 64 + lane) * 4) = acc1;
        __syncthreads();
        { const int row = tid >> 4, col = tid & 15, mb = row >> 4, rr = row & 15, ln = col + 16 * (rr >> 2), rg = rr & 3; float s = 0.f;
#pragma unroll
          for (int w = 0; w < 8; ++w) s += red[((w * 2 + mb) * 64 + ln) * 4 + rg];
          E(row, u * 16 + col, s); }
        __syncthreads();
    }
}

constexpr int SKA_STRIDE = 2064, SKA_RSTD = 32 * SKA_STRIDE, SKA_RED = SKA_RSTD + 512;
template <class Epi>
__device__ __forceinline__ void skinny_gemm_hs(LAS unsigned char* lds, const float* __restrict__ HS, const bf16* __restrict__ Wt, int N, const Epi& E) {
    int tid_l = threadIdx.x; asm volatile("" : "+v"(tid_l)); const int tid = tid_l, lane = tid & 63, wid = tid >> 6;
    if ((int)blockIdx.x >= (N >> 4)) return;
    LAS float* rstd_l = (LAS float*)(lds + SKA_RSTD); LAS float* red = (LAS float*)(lds + SKA_RED);
    { const int row = tid >> 4, c16 = tid & 15; const float* src = HS + row * DM + c16 * 64; float ss = 0.f;
#pragma unroll
      for (int i = 0; i < 16; i += 2) { const f32x4 a = *(const f32x4*)(src + 4 * i), b = *(const f32x4*)(src + 4 * i + 4);
          ss += (a.x * a.x + a.y * a.y) + (a.z * a.z + a.w * a.w) + (b.x * b.x + b.y * b.y) + (b.z * b.z + b.w * b.w);
          v4u w; w.x = pk2(a.x, a.y); w.y = pk2(a.z, a.w); w.z = pk2(b.x, b.y); w.w = pk2(b.z, b.w);
          *(LAS v4u*)(lds + row * SKA_STRIDE + (c16 * 64 + 4 * i) * 2) = w; }
      ss += __shfl_xor(ss, 1); ss += __shfl_xor(ss, 2); ss += __shfl_xor(ss, 4); ss += __shfl_xor(ss, 8);
      if (c16 == 0) rstd_l[row] = rsqrtf(ss * (1.f / DM) + EPS); }
    __syncthreads();
    const int kbeg = wid * 128;
    for (int u = blockIdx.x; u < (N >> 4); u += gridDim.x) {
        f32x4 acc0 = {0.f, 0.f, 0.f, 0.f}, acc1 = {0.f, 0.f, 0.f, 0.f};
        const bf16* wrow = Wt + (size_t)(u * 16 + (lane & 15)) * DM + kbeg + 8 * (lane >> 4);
        const LAS unsigned char* a0 = lds + (lane & 15) * SKA_STRIDE + (kbeg + 8 * (lane >> 4)) * 2;
#pragma unroll
        for (int k = 0; k < 128; k += 32) {
            const bf16x8 b = *(const bf16x8*)(wrow + k), x0 = *(const LAS bf16x8*)(a0 + 2 * k), x1 = *(const LAS bf16x8*)(a0 + 16 * SKA_STRIDE + 2 * k);
            acc0 = __builtin_amdgcn_mfma_f32_16x16x32_bf16(x0, b, acc0, 0, 0, 0);
            acc1 = __builtin_amdgcn_mfma_f32_16x16x32_bf16(x1, b, acc1, 0, 0, 0);
        }
        *(LAS f32x4*)(red + ((wid * 2 + 0) * 64 + lane) * 4) = acc0;
        *(LAS f32x4*)(red + ((wid * 2 + 1) * 64 + lane) * 4) = acc1;
        __syncthreads();
        { const int row = tid >> 4, col = tid & 15, mb = row >> 4, rr = row & 15, ln = col + 16 * (rr >> 2), rg = rr & 3; float s = 0.f;
#pragma unroll
          for (int w = 0; w < 8; ++w) s += red[((w * 2 + mb) * 64 + ln) * 4 + rg];
          E(row, u * 16 + col, s * rstd_l[row]); }
        __syncthreads();
    }
}
struct SkUV { float* usu; float* vsf; __device__ __forceinline__ void operator()(int r, int c, float s) const { if (c < DM) usu[r * DM + c] = s; else vsf[r * DM + c - DM] = s; } };
struct SkResid { float* hs; __device__ __forceinline__ void operator()(int r, int c, float s) const { hs[r * DM + c] += s; } };
struct SkSqRelu { bf16* h; __device__ __forceinline__ void operator()(int r, int c, float s) const { const float a = fmaxf(s, 0.f); h[r * FF + c] = (bf16)(pk2(a * a, 0.f) & 0xffffu); } };
struct SkKVQG { float* out; float* qs; float* gs; const float* bg; int col_off;
    __device__ __forceinline__ void operator()(int r, int c0, float s) const { const int c = c0 + col_off;
        if (c < 512) out[O_CMPS + r * 512 + c] = s;
        else if (c < 1024) out[O_SELS + r * 512 + c - 512] = s;
        else if (c < 1536) out[O_WINS + (size_t)(r * 512 + 511) * 512 + c - 1024] = s;
        else if (c < 2560) qs[r * DM + c - 1536] = s * C2;
        else if (c < 2608) gs[r * 48 + c - 2560] = 1.f / (1.f + __expf(-(s + bg[c - 2560]))); } };

__device__ const unsigned char NSA_QB[128] = {112, 72, 46, 6, 104, 98, 31, 3, 95, 75, 50, 16, 123, 88, 21, 4, 110, 74, 39, 13, 103, 67, 61, 5, 83, 79, 56, 18, 118, 49, 42, 27, 106, 45, 44, 41, 100, 70, 55, 11, 102, 58, 40, 36, 85, 62, 51, 38, 125, 47, 35, 29, 127, 65, 25, 19, 119, 76, 32, 9, 109, 53, 48, 26, 122, 89, 59, 2, 105, 91, 52, 24, 111, 90, 37, 34, 96, 87, 81, 8, 117, 69, 64, 22, 126, 66, 57, 23, 114, 80, 71, 7, 97, 84, 77, 14, 107, 93, 60, 12, 101, 92, 78, 1, 115, 94, 33, 30, 113, 86, 73, 0, 116, 82, 54, 20, 124, 68, 63, 17, 121, 108, 28, 15, 120, 99, 43, 10};
struct Frame {
    LAS unsigned char* lds; volatile LAS unsigned* MISC;
    int tid, lane, wave, G, gw, NGW;
    unsigned char* ws; float* out;
};
constexpr int PTAB_OFF = LDSCTL_OFF + 1024;
__device__ __forceinline__ const void* tab_ptr(LAS unsigned char* lds, int i) {
    const unsigned long long v = *(volatile LAS unsigned long long*)(lds + PTAB_OFF + 8 * i);
    const unsigned lo = __builtin_amdgcn_readfirstlane((unsigned)v), hi = __builtin_amdgcn_readfirstlane((unsigned)(v >> 32));
    const GAS char* gp = (const GAS char*)(((unsigned long long)hi << 32) | lo);
    return (const void*)gp;
}
#define INF(i) ((const float*)tab_ptr(F.lds, (i)))

struct TTask { const float* W; int ld, col0, ncols; const float* gain; bf16* dst; int K, npad, ilv; };
__device__ __forceinline__ void transpose_item(const TTask& T, LAS float* scr, int item, int lane) {
    const int nblk = T.npad >> 5, kb = item / nblk, nb = item - kb * nblk, k0 = 64 * kb, n0 = 32 * nb;
    const int n = n0 + (lane & 31); const bool ok = n < T.ncols;
    const int k0d = T.ilv ? ((kb & 15) * 128 + (kb >> 4) * 64) : k0;
    float wv[32];
#pragma unroll
    for (int i = 0; i < 32; ++i) { const int kk = 2 * i + (lane >> 5); wv[i] = ok ? T.W[(size_t)(k0 + kk) * T.ld + T.col0 + n] : 0.f; }
#pragma unroll
    for (int i = 0; i < 32; ++i) { const int kk = 2 * i + (lane >> 5); float w = wv[i]; if (T.gain) w *= T.gain[k0 + kk]; scr[kk * 33 + (lane & 31)] = w; }
    LDS_WAIT(); asm volatile("" ::: "memory");
    const int c = lane & 7;
#pragma unroll
    for (int j = 0; j < 4; ++j) { const int nn = (lane >> 3) + 8 * j; const LAS float* s = scr + (8 * c) * 33 + nn;
        v4u o; o.x = pk2(s[0 * 33], s[1 * 33]); o.y = pk2(s[2 * 33], s[3 * 33]); o.z = pk2(s[4 * 33], s[5 * 33]); o.w = pk2(s[6 * 33], s[7 * 33]);
        *(v4u*)(T.dst + (size_t)(n0 + nn) * T.K + k0d + 8 * c) = o; }
    LDS_WAIT(); asm volatile("" ::: "memory");
}
constexpr int N_TTASK = 29;
__device__ __forceinline__ int get_ttask(Frame& F, int t, TTask& T) {
    unsigned char* ws = F.ws;
    if (t < 2)       { const int i = t;      T = TTask{INF(7) + (size_t)i * 1024 * 2048, 2048, 0, 2048, INF(6) + i * 1024, (bf16*)(ws + WS_WUV) + (size_t)i * 2048 * 1024, 1024, 2048}; }
    else if (t < 4)  { const int i = t - 2;  T = TTask{INF(11) + (size_t)i * 1024 * 1024, 1024, 0, 1024, nullptr, (bf16*)(ws + WS_WAO) + (size_t)i * 1024 * 1024, 1024, 1024}; }
    else if (t == 4) {                       T = TTask{INF(13), 1536, 0, 1536, INF(12), (bf16*)(ws + WS_WKVQG), 1024, 1536}; }
    else if (t == 5) {                       T = TTask{INF(21), 1072, 0, 1024, INF(20), (bf16*)(ws + WS_WKVQG) + (size_t)1536 * 1024, 1024, 1024}; }
    else if (t == 6) {                       T = TTask{INF(21), 1072, 1024, 48, INF(20), (bf16*)(ws + WS_WKVQG) + (size_t)2560 * 1024, 1024, 256}; }
    else if (t == 7) {                       T = TTask{INF(21) + (size_t)1024 * 1072, 1072, 0, 1024, INF(20) + 1024, (bf16*)(ws + WS_WQG1), 1024, 1024}; }
    else if (t == 8) {                       T = TTask{INF(21) + (size_t)1024 * 1072, 1072, 1024, 48, INF(20) + 1024, (bf16*)(ws + WS_WQG1) + (size_t)1024 * 1024, 1024, 256}; }
    else if (t < 11) { const int i = t - 9;  T = TTask{INF(23) + (size_t)i * 1024 * 1024, 1024, 0, 1024, nullptr, (bf16*)(ws + WS_WBO) + (size_t)i * 1024 * 1024, 1024, 1024}; }
    else if (t < 15) { const int i = t - 11; T = TTask{INF(25) + (size_t)i * 1024 * 4096, 4096, 0, 4096, INF(24) + i * 1024, (bf16*)(ws + WS_WUP) + (size_t)i * 4096 * 1024, 1024, 4096}; }
    else if (t < 19) { const int i = t - 15; T = TTask{INF(26) + (size_t)i * 4096 * 1024, 1024, 0, 1024, nullptr, (bf16*)(ws + WS_WDN) + (size_t)i * 1024 * 4096, 4096, 1024}; }
    else if (t < 23) { const int i = t - 19, kv = i >> 1, half = i & 1;
                       T = TTask{INF(kv ? 18 : 15) + (size_t)half * 1024 * 256, 256, 0, 256, nullptr, (bf16*)(ws + WS_WC1) + (size_t)kv * 512 * 1024 + (size_t)half * 256 * 1024, 1024, 256}; }
    else if (t < 25) { const int kv = t - 23; T = TTask{INF(kv ? 19 : 16), 64, 0, 64, nullptr, (bf16*)(ws + WS_WC2) + (size_t)kv * 64 * 256, 256, 64}; }
    else if (t < 27) { const int kv = t - 25; T = TTask{INF(kv ? 18 : 15), 256, 0, 256, nullptr, (bf16*)(ws + WS_WC1F) + (size_t)kv * 256 * 2048, 2048, 256, 1}; }
    else             { T = TTask{nullptr, 0, 0, 0, nullptr, nullptr, 64, 32}; return 0; }
    return (T.K >> 6) * (T.npad >> 5);
}
__device__ __forceinline__ void cvt_row_bf16_ssq(const float* xrow, bf16* orow, float* rs16, int lane) {
    const f32x4* xr = (const f32x4*)xrow + lane; f32x4 v[4]; float s = 0.f;
#pragma unroll
    for (int j = 0; j < 4; ++j) { v[j] = xr[64 * j]; s += (v[j].x * v[j].x + v[j].y * v[j].y) + (v[j].z * v[j].z + v[j].w * v[j].w); }
    s = wave_sum(s);
    unsigned long long* o8 = (unsigned long long*)orow + lane;
#pragma unroll
    for (int j = 0; j < 4; ++j) o8[64 * j] = (unsigned long long)pk2(v[j].x, v[j].y) | ((unsigned long long)pk2(v[j].z, v[j].w) << 32);
    if (lane < 16) rs16[lane] = lane == 0 ? s : 0.f;
}
__device__ __forceinline__ void norm_row_f32(const float* xrow, const float* g, float* orow, int lane) {
    const f32x4* xr = (const f32x4*)xrow + lane; const f32x4* gr = (const f32x4*)g + lane; f32x4 v[4]; float s = 0.f;
#pragma unroll
    for (int j = 0; j < 4; ++j) { v[j] = xr[64 * j]; s += (v[j].x * v[j].x + v[j].y * v[j].y) + (v[j].z * v[j].z + v[j].w * v[j].w); }
    const float rstd = rsqrtf(wave_sum(s) * (1.f / DM) + EPS);
#pragma unroll
    for (int j = 0; j < 4; ++j) { const f32x4 gg = gr[64 * j]; ((f32x4*)orow + lane)[64 * j] = v[j] * rstd * gg; }
}
__device__ __forceinline__ void norm_row_bf16(const bf16* xrow, const float* rs16, const float* g, float* orow, int lane) {
    const v4u a = *(const v4u*)(xrow + 8 * lane), b = *(const v4u*)(xrow + 512 + 8 * lane);
    float t = lane < 16 ? rs16[lane] : 0.f; t = wave_sum(t);
    const float rstd = rsqrtf(t * (1.f / DM) + EPS);
    const f32x4* gr = (const f32x4*)g; f32x4* o4 = (f32x4*)orow;
    const f32x4 g0 = gr[2 * lane], g1 = gr[2 * lane + 1], g2 = gr[128 + 2 * lane], g3 = gr[128 + 2 * lane + 1];
    o4[2 * lane]           = (f32x4){bf_lo(a.x), bf_hi(a.x), bf_lo(a.y), bf_hi(a.y)} * rstd * g0;
    o4[2 * lane + 1]       = (f32x4){bf_lo(a.z), bf_hi(a.z), bf_lo(a.w), bf_hi(a.w)} * rstd * g1;
    o4[128 + 2 * lane]     = (f32x4){bf_lo(b.x), bf_hi(b.x), bf_lo(b.y), bf_hi(b.y)} * rstd * g2;
    o4[128 + 2 * lane + 1] = (f32x4){bf_lo(b.z), bf_hi(b.z), bf_lo(b.w), bf_hi(b.w)} * rstd * g3;
}
__device__ __forceinline__ void prologue_phase(Frame& F) {
    LAS float* scr = (LAS float*)(F.lds + F.wave * 16384);
    for (int it = F.gw; ; it += F.NGW) {
        int r = it, t = 0; TTask T; int n = 0;
        for (; t < N_TTASK; ++t) { n = get_ttask(F, t, T); if (n == 0 || r < n) break; r -= n; }
        if (n == 0 || t >= N_TTASK) break;
        transpose_item(T, scr, r, F.lane);
    }
    { const float* Ws = INF(9); bf16* Wsb = (bf16*)(F.ws + WS_WSB);
      for (int i = F.gw * 64 + F.lane; i < 2 * 8 * 128 * 128; i += F.NGW * 64) { const int s = i & 127, t = (i >> 7) & 127; const float w = (s <= t) ? Ws[i] : 0.f; Wsb[i] = (bf16)(pk2(w, 0.f) & 0xffffu); } }
    { float* bias1 = (float*)(F.ws + WS_BIAS1);
      for (int o = F.gw; o < 512; o += F.NGW) { const int kv = o >> 8, n = o & 255; const float* pe = INF(kv ? 17 : 14); const float* w1 = INF(kv ? 18 : 15); float s = 0.f;
          for (int kk = F.lane; kk < 2048; kk += 64) s += pe[kk] * w1[(size_t)kk * 256 + n];
          s = wave_sum(s); if (F.lane == 0) bias1[o] = s; } }
    { const float* xp = INF(0); const float* xs = INF(1); bf16* XN = (bf16*)(F.ws + WS_XN); float* RS2 = (float*)(F.ws + WS_ROWSS2); float* HS = (float*)(F.ws + WS_HS);
      for (int m = F.gw; m < MP + NS; m += F.NGW) {
          if (m < MP) cvt_row_bf16_ssq(xp + (size_t)m * DM, XN + (size_t)m * DM, RS2 + (size_t)m * 16, F.lane);
          else { const int r = m - MP;
#pragma unroll
                 for (int j = 0; j < 4; ++j) ((f32x4*)(HS + (size_t)r * DM) + F.lane)[64 * j] = ((const f32x4*)(xs + (size_t)r * DM) + F.lane)[64 * j]; } } }
    { const float* cache = INF(2); const int* pt = (const int*)tab_ptr(F.lds, 5); bf16* acmp = (bf16*)(F.ws + WS_ACMP);
      for (int it = F.gw; it < NS * 512; it += F.NGW) { const int seq = it >> 9, jblk = it & 511; const int page = pt[seq * 64 + (jblk >> 3)];
          const float* src = cache + ((size_t)page * 128 + (jblk & 7) * 16) * 512;
#pragma unroll
          for (int i0 = 0; i0 < 32; i0 += 16) { f32x4 v[16];
#pragma unroll
              for (int j = 0; j < 16; ++j) v[j] = __builtin_nontemporal_load((const f32x4*)(src + (i0 + j) * 256 + F.lane * 4));
#pragma unroll
              for (int j = 0; j < 16; ++j) { const int i = i0 + j, r = i >> 1, kv = i & 1, g = F.lane >> 4, d = (F.lane & 15) * 4;
                  v2u w; w.x = pk2(v[j].x, v[j].y); w.y = pk2(v[j].z, v[j].w);
                  *(v2u*)(acmp + ((size_t)kv * ACMP_ROWS + (size_t)(it * 4 + g)) * 1024 + r * 64 + d) = w; } } } }
    { const float* st = INF(4); float* o = F.out + O_WINS;
      for (int it = F.gw * 4; it < NS * 511; it += F.NGW * 4) { f32x4 v[8];
#pragma unroll
          for (int j = 0; j < 4; ++j) { const int x = it + j < NS * 511 ? it + j : NS * 511 - 1, seq = x / 511, r = x - seq * 511;
              const f32x4* s4 = (const f32x4*)(st + (size_t)(seq * 512 + r + 1) * 512) + F.lane; v[2 * j] = s4[0]; v[2 * j + 1] = s4[64]; }
#pragma unroll
          for (int j = 0; j < 4; ++j) { const int x = it + j < NS * 511 ? it + j : NS * 511 - 1, seq = x / 511, r = x - seq * 511;
              f32x4* d4 = (f32x4*)(o + (size_t)(seq * 512 + r) * 512) + F.lane; d4[0] = v[2 * j]; d4[64] = v[2 * j + 1]; } } }
}

constexpr int GT_STRIDE = 272;
__device__ __forceinline__ void gating_phase(Frame& F, int layer, bf16* Uout) {
    bf16* U = (bf16*)(F.ws + WS_U); const bf16* V = (const bf16*)(F.ws + WS_V); const float* rowss = (const float*)(F.ws + WS_ROWSS);
    const bf16* Wsb = (const bf16*)(F.ws + WS_WSB) + (size_t)layer * 8 * 128 * 128;
    const float* gv = INF(8) + layer * DM; const float* bs = INF(10) + layer * 8 * 128;
    LAS unsigned char* vt = F.lds; LAS float* rstd_l = (LAS float*)(F.lds + 128 * GT_STRIDE);
    const int tid = F.tid, lane = F.lane, w = F.wave;
    for (int un = blockIdx.x; un < 1024; un += F.G) {
        const int chunk = un >> 3, g = un & 7, row0 = chunk * 128;
        if (tid < 128) { const float* p = rowss + (size_t)(row0 + tid) * 16; float s = 0.f;
#pragma unroll
            for (int i = 0; i < 16; ++i) s += p[i];
            rstd_l[tid] = rsqrtf(s * (1.f / DM) + EPS); }
        __syncthreads();
#pragma unroll
        for (int it = 0; it < 4; ++it) { const int idx = it * 512 + tid, r = idx >> 4, ch = idx & 15;
            v4u x = *(const v4u*)(V + (size_t)(row0 + r) * DM + g * 128 + ch * 8); const float rs = rstd_l[r];
            v4u y; y.x = pk2(bf_lo(x.x) * rs, bf_hi(x.x) * rs); y.y = pk2(bf_lo(x.y) * rs, bf_hi(x.y) * rs); y.z = pk2(bf_lo(x.z) * rs, bf_hi(x.z) * rs); y.w = pk2(bf_lo(x.w) * rs, bf_hi(x.w) * rs);
            *(LAS v4u*)(vt + r * GT_STRIDE + ch * 16) = y; }
        __syncthreads();
        f32x4 acc[8];
#pragma unroll
        for (int nt = 0; nt < 8; ++nt) acc[nt] = (f32x4){0.f, 0.f, 0.f, 0.f};
        const int kmax = (16 * w + 15) >> 5;
        const bf16* wrow = Wsb + ((size_t)g * 128 + 16 * w + (lane & 15)) * 128 + 8 * (lane >> 4);
        const int i16 = lane & 15, gidx = lane >> 4;
#pragma unroll
        for (int ks = 0; ks < 4; ++ks) if (ks <= kmax) {
            const bf16x8 wf = *(const bf16x8*)(wrow + 32 * ks);
            LAS unsigned char* vb = vt + (32 * ks + 8 * gidx + (i16 >> 2)) * GT_STRIDE + (4 * (i16 & 3)) * 2;
#pragma unroll
            for (int nt = 0; nt < 8; ++nt) {
                const s16x4 lo = __builtin_bit_cast(s16x4, __builtin_amdgcn_ds_read_tr16_b64_v4i16((LAS s16x4*)(vb + nt * 32)));
                const s16x4 hi = __builtin_bit_cast(s16x4, __builtin_amdgcn_ds_read_tr16_b64_v4i16((LAS s16x4*)(vb + nt * 32 + 4 * GT_STRIDE)));
                const bf16x8 vf = {lo[0], lo[1], lo[2], lo[3], hi[0], hi[1], hi[2], hi[3]};
                acc[nt] = __builtin_amdgcn_mfma_f32_16x16x32_bf16(vf, wf, acc[nt], 0, 0, 0);
            }
        }
        { const int tl = 16 * w + (lane & 15); const float bst = bs[g * 128 + tl]; const size_t ro = (size_t)(row0 + tl) * DM + g * 128 + 4 * (lane >> 4);
          v2u ux[8]; f32x4 gg[8];
#pragma unroll
          for (int nt = 0; nt < 8; ++nt) { ux[nt] = *(const v2u*)(U + ro + nt * 16); gg[nt] = *(const f32x4*)(gv + g * 128 + 4 * (lane >> 4) + nt * 16); }
          asm volatile("" ::: "memory");
#pragma unroll
          for (int nt = 0; nt < 8; ++nt) { const size_t o = ro + nt * 16;
              v2u r; r.x = pk2(bf_lo(ux[nt].x) * (acc[nt][0] * gg[nt].x + bst), bf_hi(ux[nt].x) * (acc[nt][1] * gg[nt].y + bst)); r.y = pk2(bf_lo(ux[nt].y) * (acc[nt][2] * gg[nt].z + bst), bf_hi(ux[nt].y) * (acc[nt][3] * gg[nt].w + bst));
              *(v2u*)(Uout + o) = r; } }
        __syncthreads();
    }
    if (blockIdx.x < NS) { const int r = blockIdx.x; const float* usu = (const float*)(F.ws + WS_USU) + r * DM; const float* vsf = (const float*)(F.ws + WS_VSF) + r * DM;
        bf16* uss = (bf16*)(F.ws + WS_USS) + r * DM; float* av = F.out + O_AV + (size_t)(layer * NS + r) * DM; const float* Ws = INF(9) + (size_t)layer * 8 * 128 * 128;
        LAS float* red = (LAS float*)F.lds;
        const float v0 = vsf[tid], v1 = vsf[tid + 512]; float s = wave_sum(v0 * v0 + v1 * v1);
        if (lane == 0) red[w] = s;
        __syncthreads();
        float tot = 0.f;
#pragma unroll
        for (int i = 0; i < 8; ++i) tot += red[i];
        const float rstd = rsqrtf(tot * (1.f / DM) + EPS);
#pragma unroll
        for (int h = 0; h < 2; ++h) { const int c = tid + 512 * h, g = c >> 7; const float vn = (h ? v1 : v0) * rstd * gv[c]; av[c] = vn;
            const float sg = Ws[(size_t)g * 128 * 128] * vn + bs[g * 128]; uss[c] = (bf16)(pk2(usu[c] * sg, 0.f) & 0xffffu); }
        __syncthreads();
    }
}

namespace nsa {
constexpr int KS = 144, VS = 192;
constexpr int KBUF = 64 * KS, VBUF = 64 * VS;
constexpr int L_K = 0, L_V = 2 * KBUF, L_IMPA = L_V + 2 * VBUF, IMP_LD = 132, L_IMPB = L_IMPA + 64 * IMP_LD * 4, L_K2 = 0, KBUF2 = 128 * KS, L_V2 = 2 * KBUF2, VBUF2 = 128 * VS, L_STASH = L_V2 + 2 * VBUF2, L_SELM = L_STASH + 8 * 4096, L_END = L_SELM + 64 * 16;
static_assert(L_SELM >= L_IMPB + 64 * IMP_LD * 4, "selection masks clear of the importance tables");
static_assert(L_END <= LDSCTL_OFF, "attention LDS map");
constexpr float NEG = -1e30f;
struct TileRegs { v4u k, v; };
__device__ __forceinline__ TileRegs tile_load(const bf16* Kp, const bf16* Vp, int stride, int row0, int rmax, int tid) {
    int r = row0 + (tid >> 3); r = r < 0 ? 0 : (r > rmax ? rmax : r); const int ch = tid & 7; TileRegs t;
    t.k = *(const v4u*)(Kp + (size_t)r * stride + ch * 8); t.v = *(const v4u*)(Vp + (size_t)r * stride + ch * 8); return t;
}
__device__ __forceinline__ void tile_store(LAS unsigned char* lds, int buf, const TileRegs& t, int tid) {
    const int r = tid >> 3, ch = tid & 7;
    *(LAS v4u*)(lds + L_K + buf * KBUF + r * KS + ch * 16) = t.k;
    *(LAS v4u*)(lds + L_V + buf * VBUF + r * VS + ch * 16) = t.v;
}
__device__ __forceinline__ void load_k_frags(bf16x8 (&kf)[8], const LAS unsigned char* kb, int r32, int hi) {
    const LAS unsigned char* ka = kb + r32 * KS + hi * 16;
#pragma unroll
    for (int d0 = 0; d0 < 4; ++d0) { kf[2 * d0] = *(const LAS bf16x8*)(ka + d0 * 32); kf[2 * d0 + 1] = *(const LAS bf16x8*)(ka + 32 * KS + d0 * 32); }
}
template <int HALF>
__device__ __forceinline__ void load_v_frags(bf16x8 (&vf)[8], const LAS unsigned char* vb, int lane) {
    const int g4 = lane >> 4, h = g4 >> 1, cb = g4 & 1, i = lane & 15;
    const LAS unsigned char* va = vb + (4 * h + (i >> 2)) * VS + (16 * cb + 4 * (i & 3)) * 2;
#pragma unroll
    for (int ks = 2 * HALF; ks < 2 * HALF + 2; ++ks)
#pragma unroll
        for (int db = 0; db < 2; ++db) { const LAS unsigned char* a = va + 16 * ks * VS + 64 * db;
            const s16x4 lo = __builtin_bit_cast(s16x4, __builtin_amdgcn_ds_read_tr16_b64_v4i16((LAS s16x4*)(a)));
            const s16x4 hi4 = __builtin_bit_cast(s16x4, __builtin_amdgcn_ds_read_tr16_b64_v4i16((LAS s16x4*)(a + 8 * VS)));
            vf[2 * ks + db] = (bf16x8){lo[0], lo[1], lo[2], lo[3], hi4[0], hi4[1], hi4[2], hi4[3]}; }
}
__device__ __forceinline__ void qk_mma(f32x16& p0, f32x16& p1, const bf16x8 (&kf)[8], const bf16x8 (&qr)[4], float m) {
    const f32x16 z = {0.f, 0.f, 0.f, 0.f, 0.f, 0.f, 0.f, 0.f, 0.f, 0.f, 0.f, 0.f, 0.f, 0.f, 0.f, 0.f};
    p0 = __builtin_amdgcn_mfma_f32_32x32x16_bf16(kf[0], qr[0], z, 0, 0, 0); p1 = __builtin_amdgcn_mfma_f32_32x32x16_bf16(kf[1], qr[0], z, 0, 0, 0);
#pragma unroll
    for (int d0 = 1; d0 < 4; ++d0) { p0 = __builtin_amdgcn_mfma_f32_32x32x16_bf16(kf[2 * d0], qr[d0], p0, 0, 0, 0); p1 = __builtin_amdgcn_mfma_f32_32x32x16_bf16(kf[2 * d0 + 1], qr[d0], p1, 0, 0, 0); }
    if (__any(m != 0.f)) {
#pragma unroll
        for (int r = 0; r < 16; ++r) { p0[r] -= m; p1[r] -= m; } }
}
__device__ __forceinline__ void mask_tile(f32x16& p0, f32x16& p1, int key0, int lo, int hi_lim, bool rowsel, int hi) {
    const int kb = key0 + 4 * hi;
#pragma unroll
    for (int r = 0; r < 16; ++r) { const int k = kb + (r & 3) + 8 * (r >> 2);
        p0[r] = (rowsel && k >= lo && k <= hi_lim) ? p0[r] : NEG;
        p1[r] = (rowsel && k + 32 >= lo && k + 32 <= hi_lim) ? p1[r] : NEG; }
}
__device__ __forceinline__ float tile_rowmax(const f32x16& p0, const f32x16& p1) {
    float a = fmaxf(p0[0], p1[0]);
#pragma unroll
    for (int r = 1; r < 16; ++r) a = fmaxf(a, fmaxf(p0[r], p1[r]));
    return swap_max(a);
}
__device__ __forceinline__ void pv_mma(f32x16& o0, f32x16& o1, const bf16x8 (&vf)[8], const f32x16& p0, const f32x16& p1, unsigned amask) {
#pragma unroll
    for (int hh = 0; hh < 2; ++hh)
#pragma unroll
        for (int s = 0; s < 2; ++s) {
            v4u pw;
            if (hh == 0) { pw.x = pk2(p0[8 * s + 0], p0[8 * s + 1]); pw.y = pk2(p0[8 * s + 2], p0[8 * s + 3]); pw.z = pk2(p0[8 * s + 4], p0[8 * s + 5]); pw.w = pk2(p0[8 * s + 6], p0[8 * s + 7]); }
            else         { pw.x = pk2(p1[8 * s + 0], p1[8 * s + 1]); pw.y = pk2(p1[8 * s + 2], p1[8 * s + 3]); pw.z = pk2(p1[8 * s + 4], p1[8 * s + 5]); pw.w = pk2(p1[8 * s + 6], p1[8 * s + 7]); }
            pw.x &= amask; pw.y &= amask; pw.z &= amask; pw.w &= amask;
            const bf16x8 pb = __builtin_bit_cast(bf16x8, pw);
            o0 = __builtin_amdgcn_mfma_f32_32x32x16_bf16(vf[2 * (2 * hh + s)], pb, o0, 0, 0, 0);
            o1 = __builtin_amdgcn_mfma_f32_32x32x16_bf16(vf[2 * (2 * hh + s) + 1], pb, o1, 0, 0, 0);
        }
}
__device__ __forceinline__ float soft_tile(f32x16& p0, f32x16& p1) {
    float s0 = 0.f, s1 = 0.f;
#pragma unroll
    for (int r = 0; r < 16; ++r) { p0[r] = fast_exp2(p0[r]); p1[r] = fast_exp2(p1[r]); s0 += p0[r]; s1 += p1[r]; }
    return s0 + s1;
}
constexpr float L_BIG = 1048576.f;
template <bool WITH_O>
__device__ __forceinline__ void ref_shift(float& m, float& l, f32x16& o0, f32x16& o1) {
    const float lm = swap_max(l);
    if (__any(lm > L_BIG)) { const float d = lm > L_BIG ? 20.f : 0.f, alpha = lm > L_BIG ? (1.f / L_BIG) : 1.f; m += d; l *= alpha;
        if (WITH_O) {
#pragma unroll
            for (int r = 0; r < 16; ++r) { o0[r] *= alpha; o1[r] *= alpha; } } }
}
template <bool MASKED>
__device__ __forceinline__ void att_step(const LAS unsigned char* kb, const LAS unsigned char* vb, const bf16x8 (&qr)[4], float& m, float& l, f32x16& o0, f32x16& o1,
                                         int key0, int lo, int hi_lim, bool rsel, int r32, int hi, int lane) {
    f32x16 p0, p1; bf16x8 kf[8], vf[8];
    load_k_frags(kf, kb, r32, hi); load_v_frags<0>(vf, vb, lane);
    __builtin_amdgcn_sched_barrier(0);
    qk_mma(p0, p1, kf, qr, m);
    __builtin_amdgcn_sched_barrier(0);
    load_v_frags<1>(vf, vb, lane);
    __builtin_amdgcn_sched_barrier(0);
    if (MASKED) mask_tile(p0, p1, key0, lo, hi_lim, rsel, hi);
    float s = soft_tile(p0, p1);
    if (!MASKED) s = rsel ? s : 0.f;
    l += s;
    pv_mma(o0, o1, vf, p0, p1, (MASKED || rsel) ? 0xffffffffu : 0u);
    ref_shift<true>(m, l, o0, o1);
}
#define NSA_SB __builtin_amdgcn_sched_barrier(0)
#define NSA_EXP4(P, B, S) do { P[(B)] = fast_exp2(P[(B)]); P[(B) + 1] = fast_exp2(P[(B) + 1]); P[(B) + 2] = fast_exp2(P[(B) + 2]); P[(B) + 3] = fast_exp2(P[(B) + 3]); S += (P[(B)] + P[(B) + 1]) + (P[(B) + 2] + P[(B) + 3]); } while (0)
#define NSA_PACK8(P, B, W, MASK) do { W.x = pk2(P[(B) + 0], P[(B) + 1]) & (MASK); W.y = pk2(P[(B) + 2], P[(B) + 3]) & (MASK); W.z = pk2(P[(B) + 4], P[(B) + 5]) & (MASK); W.w = pk2(P[(B) + 6], P[(B) + 7]) & (MASK); } while (0)
#define NSA_MF(D, A, Bq) D = __builtin_amdgcn_mfma_f32_32x32x16_bf16(A, Bq, D, 0, 0, 0)
#define NSA_PVS(VF, W, I) do { const bf16x8 pb_ = __builtin_bit_cast(bf16x8, W); NSA_MF(o0, VF[2 * (I)], pb_); NSA_MF(o1, VF[2 * (I) + 1], pb_); } while (0)
__device__ __forceinline__ void att_step2(const LAS unsigned char* kba, const LAS unsigned char* vba, const LAS unsigned char* kbb, const LAS unsigned char* vbb, const bf16x8 (&qr)[4],
                                          float& m, float& l, f32x16& o0, f32x16& o1, bool rsela, bool rselb, int r32, int hi, int lane) {
    f32x16 pa0, pa1, pb0, pb1; bf16x8 kf[8], vfa[8], vfb[8];
    const f32x16 z = {0.f, 0.f, 0.f, 0.f, 0.f, 0.f, 0.f, 0.f, 0.f, 0.f, 0.f, 0.f, 0.f, 0.f, 0.f, 0.f};
    const unsigned ma = rsela ? 0xffffffffu : 0u, mb = rselb ? 0xffffffffu : 0u;
    const LAS unsigned char* kab = kbb + r32 * KS + hi * 16;
    load_k_frags(kf, kba, r32, hi);
    NSA_SB;
    pa0 = __builtin_amdgcn_mfma_f32_32x32x16_bf16(kf[0], qr[0], z, 0, 0, 0); pa1 = __builtin_amdgcn_mfma_f32_32x32x16_bf16(kf[1], qr[0], z, 0, 0, 0);
    NSA_MF(pa0, kf[2], qr[1]); NSA_MF(pa1, kf[3], qr[1]); NSA_MF(pa0, kf[4], qr[2]); NSA_MF(pa1, kf[5], qr[2]); NSA_MF(pa0, kf[6], qr[3]); NSA_MF(pa1, kf[7], qr[3]);
    NSA_SB;
#pragma unroll
    for (int d0 = 0; d0 < 4; ++d0) kf[2 * d0] = *(const LAS bf16x8*)(kab + d0 * 32);
    NSA_SB;
    float sa0 = 0.f, sb0 = 0.f; v4u wa0, wa1, wa2, wa3, wb0, wb1, wb2, wb3;
    pb0 = __builtin_amdgcn_mfma_f32_32x32x16_bf16(kf[0], qr[0], z, 0, 0, 0); NSA_SB; NSA_EXP4(pa0, 0, sa0); NSA_SB;
    NSA_MF(pb0, kf[2], qr[1]); NSA_SB; NSA_EXP4(pa0, 4, sa0); NSA_PACK8(pa0, 0, wa0, ma); NSA_SB;
#pragma unroll
    for (int d0 = 0; d0 < 4; ++d0) kf[2 * d0 + 1] = *(const LAS bf16x8*)(kab + 32 * KS + d0 * 32);
    NSA_SB;
    NSA_MF(pb0, kf[4], qr[2]); NSA_SB; NSA_EXP4(pa0, 8, sa0); NSA_SB;
    NSA_MF(pb0, kf[6], qr[3]); NSA_SB; NSA_EXP4(pa0, 12, sa0); NSA_PACK8(pa0, 8, wa1, ma); NSA_SB;
    pb1 = __builtin_amdgcn_mfma_f32_32x32x16_bf16(kf[1], qr[0], z, 0, 0, 0); NSA_SB; NSA_EXP4(pa1, 0, sa0); NSA_SB;
    NSA_MF(pb1, kf[3], qr[1]); NSA_SB; NSA_EXP4(pa1, 4, sa0); NSA_PACK8(pa1, 0, wa2, ma); NSA_SB;
    NSA_MF(pb1, kf[5], qr[2]); NSA_SB; NSA_EXP4(pa1, 8, sa0); NSA_SB;
    NSA_MF(pb1, kf[7], qr[3]); NSA_SB; NSA_EXP4(pa1, 12, sa0); NSA_PACK8(pa1, 8, wa3, ma); NSA_SB;
    load_v_frags<0>(vfa, vba, lane);
    NSA_SB;
    NSA_PVS(vfa, wa0, 0); NSA_SB; load_v_frags<1>(vfa, vba, lane); NSA_EXP4(pb0, 0, sb0); NSA_EXP4(pb0, 4, sb0); NSA_PACK8(pb0, 0, wb0, mb); NSA_SB;
    NSA_PVS(vfa, wa1, 1); NSA_SB; NSA_EXP4(pb0, 8, sb0); NSA_EXP4(pb0, 12, sb0); NSA_PACK8(pb0, 8, wb1, mb); NSA_SB;
    NSA_PVS(vfa, wa2, 2); NSA_SB; load_v_frags<0>(vfb, vbb, lane); NSA_EXP4(pb1, 0, sb0); NSA_EXP4(pb1, 4, sb0); NSA_PACK8(pb1, 0, wb2, mb); NSA_SB;
    NSA_PVS(vfa, wa3, 3); NSA_SB; load_v_frags<1>(vfb, vbb, lane); NSA_EXP4(pb1, 8, sb0); NSA_EXP4(pb1, 12, sb0); NSA_PACK8(pb1, 8, wb3, mb); NSA_SB;
    NSA_PVS(vfb, wb0, 0); NSA_PVS(vfb, wb1, 1); NSA_PVS(vfb, wb2, 2); NSA_PVS(vfb, wb3, 3);
    NSA_SB;
    l += (rsela ? sa0 : 0.f) + (rselb ? sb0 : 0.f);
    ref_shift<true>(m, l, o0, o1);
}
__device__ __forceinline__ void topk_finish(bool c0, bool c1, unsigned u0, unsigned u1, unsigned T, bool exact, int need, int lane, bool& s0, bool& s1) {
    if (exact) { s0 = c0 && u0 >= T; s1 = c1 && u1 >= T; return; }
    const bool g0 = c0 && u0 > T, g1 = c1 && u1 > T, e0 = c0 && u0 == T, e1 = c1 && u1 == T;
    const int rem = need - (__popcll(__ballot(g0)) + __popcll(__ballot(g1)));
    const unsigned long long be0 = __ballot(e0), be1 = __ballot(e1), below = (1ull << lane) - 1ull;
    const int r0 = __popcll(be0 & below), r1 = __popcll(be0) + __popcll(be1 & below);
    s0 = g0 || (e0 && r0 < rem); s1 = g1 || (e1 && r1 < rem);
}
__device__ __forceinline__ void topk_select2(bool c0a, bool c1a, unsigned u0a, unsigned u1a, bool c0b, bool c1b, unsigned u0b, unsigned u1b, int need, int lane, bool& s0a, bool& s1a, bool& s0b, bool& s1b) {
    const int ncand = __popcll(__ballot(c0a)) + __popcll(__ballot(c1a));
    if (ncand <= need) { s0a = c0a; s1a = c1a; s0b = c0b; s1b = c1b; return; }
    u0a = c0a ? u0a : 0u; u1a = c1a ? u1a : 0u; u0b = c0b ? u0b : 0u; u1b = c1b ? u1b : 0u;
    unsigned Ta = 0u, Tb = 0u; bool xa = false, xb = false;
    for (int bit = 30; bit >= 0; --bit) {
        const unsigned Tna = Ta | (1u << bit), Tnb = Tb | (1u << bit);
        const int ca = __popcll(__ballot(u0a >= Tna)) + __popcll(__ballot(u1a >= Tna)), cb = __popcll(__ballot(u0b >= Tnb)) + __popcll(__ballot(u1b >= Tnb));
        if (!xa) { if (ca >= need) Ta = Tna; xa = ca == need; }
        if (!xb) { if (cb >= need) Tb = Tnb; xb = cb == need; }
        if (xa && xb) break;
    }
    topk_finish(c0a, c1a, u0a, u1a, Ta, xa, need, lane, s0a, s1a);
    topk_finish(c0b, c1b, u0b, u1b, Tb, xb, need, lane, s0b, s1b);
}
__device__ __forceinline__ void topk_select(bool c0, bool c1, unsigned u0, unsigned u1, int need, int lane, bool& s0, bool& s1) {
    bool d0, d1; topk_select2(c0, c1, u0, u1, c0, c1, u0, u1, need, lane, s0, s1, d0, d1);
}

struct TileSrc { const bf16* K; const bf16* V; int stride, row0, rmax; };
struct Tile2Regs { v4u k0, k1, v0, v1; };
__device__ __forceinline__ Tile2Regs tile2_load(const bf16* Kp, const bf16* Vp, int row0, int tid) {
    int r = row0 + (tid >> 2); r = r > SEQ - 1 ? SEQ - 1 : r; const int c = (tid & 3) * 16; Tile2Regs t;
    const bf16* kp = Kp + (size_t)r * 512 + c; const bf16* vp = Vp + (size_t)r * 512 + c;
    t.k0 = *(const v4u*)kp; t.k1 = *(const v4u*)(kp + 8); t.v0 = *(const v4u*)vp; t.v1 = *(const v4u*)(vp + 8); return t;
}
__device__ __forceinline__ void tile2_store(LAS unsigned char* lds, int buf, const Tile2Regs& t, int tid) {
    const int r = tid >> 2, c = (tid & 3) * 32;
    *(LAS v4u*)(lds + L_K2 + buf * KBUF2 + r * KS + c) = t.k0; *(LAS v4u*)(lds + L_K2 + buf * KBUF2 + r * KS + c + 16) = t.k1;
    *(LAS v4u*)(lds + L_V2 + buf * VBUF2 + r * VS + c) = t.v0; *(LAS v4u*)(lds + L_V2 + buf * VBUF2 + r * VS + c + 16) = t.v1;
}
__device__ __forceinline__ void nsa_unit(const bf16* __restrict__ Q, const float* __restrict__ gates, const bf16* __restrict__ kc, const bf16* __restrict__ vc,
                                         const bf16* __restrict__ ksel, const bf16* __restrict__ kwin, bf16* __restrict__ O, int b, int g, int qb, LAS unsigned char* lds) {
    int tid_l = threadIdx.x; asm volatile("" : "+v"(tid_l)); const int tid = tid_l, lane = tid & 63, r32 = lane & 31, hi = lane >> 5, wid = __builtin_amdgcn_readfirstlane(tid >> 6);
    const int t0 = qb * 64, cur = qb, ql = 8 * wid + (r32 >> 2), tq = t0 + ql, head = 4 * g + (r32 & 3);
    const size_t qrow = (size_t)b * SEQ + tq;
    bf16x8 qr[4];
#pragma unroll
    for (int d0 = 0; d0 < 4; ++d0) qr[d0] = *(const bf16x8*)(Q + qrow * DM + head * 64 + 16 * d0 + 8 * hi);
    f32x16 ob0, ob1;
    LAS unsigned* stash = (LAS unsigned*)(lds + L_STASH) + wid * 1024 + lane;
    LAS float* impA = (LAS float*)(lds + L_IMPA); LAS float* impB = (LAS float*)(lds + L_IMPB); LAS unsigned long long* selm = (LAS unsigned long long*)(lds + L_SELM);
    const int nct = (((t0 + 32) >> 4) >> 6) + 1, cmax_q = (tq - 31) >> 4, cmax_w = (t0 + 8 * wid - 31) >> 4;
    const bf16* Kc = kc + (size_t)b * 512 * 256 + g * 64; const bf16* Vc = vc + (size_t)b * 512 * 256 + g * 64;
    float m = 0.f, l = 0.f, inv = 0.f;
#pragma unroll
    for (int r = 0; r < 16; ++r) { ob0[r] = 0.f; ob1[r] = 0.f; }
    { const int S1 = nct, S2 = 2 * nct; TileRegs r1;
      r1 = tile_load(Kc, Vc, 256, 0, 511, tid); tile_store(lds, 0, r1, tid);
      __syncthreads();
      for (int s = 0; s < S2; ++s) { const int buf = s & 1;
        if (s + 1 < S2) r1 = tile_load(Kc, Vc, 256, 64 * (s + 1 < S1 ? s + 1 : s + 1 - S1), 511, tid);
        const LAS unsigned char* kb = lds + L_K + buf * KBUF; const LAS unsigned char* vb = lds + L_V + buf * VBUF;
        if (s < S1) {
            f32x16 p0, p1; bf16x8 kf[8]; load_k_frags(kf, kb, r32, hi); __builtin_amdgcn_sched_barrier(0); qk_mma(p0, p1, kf, qr, m); __builtin_amdgcn_sched_barrier(0);
            if (64 * s + 63 > cmax_w) { asm volatile("; boundary tile" ::: "memory"); mask_tile(p0, p1, 64 * s, 0, cmax_q, true, hi); }
            const float s_ = soft_tile(p0, p1); l += s_; ref_shift<false>(m, l, ob0, ob1);
            if (s == S1 - 1) { l = swap_sum(l); inv = l > 0.f ? 1.f / l : 0.f; }
        } else { const int ti = s - S1;
            f32x16 p0, p1; bf16x8 kf[8], vf[8]; load_k_frags(kf, kb, r32, hi); load_v_frags<0>(vf, vb, lane); __builtin_amdgcn_sched_barrier(0); qk_mma(p0, p1, kf, qr, m); __builtin_amdgcn_sched_barrier(0); load_v_frags<1>(vf, vb, lane); __builtin_amdgcn_sched_barrier(0);
            if (64 * ti + 63 > cmax_w) { asm volatile("; boundary tile" ::: "memory"); mask_tile(p0, p1, 64 * ti, 0, cmax_q, true, hi); }
#pragma unroll
            for (int r = 0; r < 16; ++r) { p0[r] = fast_exp2(p0[r]) * inv; p1[r] = fast_exp2(p1[r]) * inv; }
#pragma unroll
            for (int hh = 0; hh < 2; ++hh)
#pragma unroll
                for (int gi = 0; gi < 4; ++gi) { float P[4];
#pragma unroll
                    for (int e = 0; e < 4; ++e) P[e] = quad_sum(hh ? p1[4 * gi + e] : p0[4 * gi + e]);
                    if ((r32 & 3) == 0) { const int j = 16 * ti + 8 * hh + 2 * gi + hi; impA[ql * IMP_LD + j] = 2.f * (P[0] + P[1] + P[2]) + P[3]; impB[ql * IMP_LD + j + 1] = P[3]; } }
            pv_mma(ob0, ob1, vf, p0, p1, 0xffffffffu);
        }
        if (s + 1 < S2) tile_store(lds, buf ^ 1, r1, tid);
        __syncthreads();
      } }
    const bf16* Ks = ksel + (size_t)b * SEQ * 512 + g * 64; const bf16* Kw = kwin + (size_t)b * SEQ * 512 + g * 64;
    Tile2Regs r2 = tile2_load(Ks, Ks + 256, 0, tid);
    unsigned long long wlo = 0ull, whi = 0ull;
    { const int nforced = cur >= 2 ? 3 : cur + 1, need = 16 - nforced;
      for (int qi = 0; qi < 8; qi += 2) { const int qa = 8 * wid + qi, qb_ = qa + 1; const int j0 = lane, j1 = lane + 64;
          const bool c0 = j0 >= 1 && j0 <= cur - 2, c1 = j1 <= cur - 2;
          const float v0a = c0 ? impA[qa * IMP_LD + j0] + impB[qa * IMP_LD + j0] : 0.f, v1a = c1 ? impA[qa * IMP_LD + j1] + impB[qa * IMP_LD + j1] : 0.f;
          const float v0b = c0 ? impA[qb_ * IMP_LD + j0] + impB[qb_ * IMP_LD + j0] : 0.f, v1b = c1 ? impA[qb_ * IMP_LD + j1] + impB[qb_ * IMP_LD + j1] : 0.f;
          bool s0a, s1a, s0b, s1b; topk_select2(c0, c1, __float_as_uint(v0a), __float_as_uint(v1a), c0, c1, __float_as_uint(v0b), __float_as_uint(v1b), need, lane, s0a, s1a, s0b, s1b);
          const bool f0 = j0 == 0 || j0 == cur || j0 == cur - 1, f1 = j1 == cur || j1 == cur - 1;
          const unsigned long long a0 = __ballot(s0a || f0), a1 = __ballot(s1a || f1), b0 = __ballot(s0b || f0), b1 = __ballot(s1b || f1);
          if (lane == 0) { selm[qa * 2 + 0] = a0; selm[qa * 2 + 1] = a1; selm[qb_ * 2 + 0] = b0; selm[qb_ * 2 + 1] = b1; } }
      __syncthreads();
      tile2_store(lds, 0, r2, tid);
#pragma unroll
      for (int i = 0; i < 8; ++i) { wlo |= selm[(8 * wid + i) * 2 + 0]; whi |= selm[(8 * wid + i) * 2 + 1]; }
      wlo = ((unsigned long long)__builtin_amdgcn_readfirstlane((unsigned)(wlo >> 32)) << 32) | (unsigned)__builtin_amdgcn_readfirstlane((unsigned)wlo);
      whi = ((unsigned long long)__builtin_amdgcn_readfirstlane((unsigned)(whi >> 32)) << 32) | (unsigned)__builtin_amdgcn_readfirstlane((unsigned)whi);
      const float gt0 = gates[qrow * 48 + head * 3 + 0];
#pragma unroll
      for (int r = 0; r < 16; ++r) { stash[64 * r] = pk2(gt0 * ob0[r], gt0 * ob1[r]); ob0[r] = 0.f; ob1[r] = 0.f; }
      m = 0.f; l = 0.f;
      __syncthreads(); }
    { const int nd = (cur >> 1) + 1;
      for (int dt = 0; dt < nd; ++dt) { const int buf = dt & 1;
          if (dt + 1 < nd) r2 = tile2_load(Ks, Ks + 256, 128 * (dt + 1), tid);
          { const int ja = 2 * dt, jb = ja + 1;
            const bool na = (((ja < 64 ? wlo : whi) >> (ja & 63)) & 1ull) != 0ull, nb = jb < cur && (((jb < 64 ? wlo : whi) >> (jb & 63)) & 1ull) != 0ull;
            if (na && nb && !__any(m != 0.f)) { const unsigned long long mq = selm[ql * 2 + (ja >> 6)]; const bool rsa = ((mq >> (ja & 63)) & 1ull) != 0ull, rsb = ((mq >> (jb & 63)) & 1ull) != 0ull;
                att_step2(lds + L_K2 + buf * KBUF2, lds + L_V2 + buf * VBUF2, lds + L_K2 + buf * KBUF2 + 64 * KS, lds + L_V2 + buf * VBUF2 + 64 * VS, qr, m, l, ob0, ob1, rsa, rsb, r32, hi, lane); }
            else {
#pragma unroll
          for (int sub = 0; sub < 2; ++sub) { const int j = 2 * dt + sub;
              const bool wneed = j <= cur && (((j < 64 ? wlo : whi) >> (j & 63)) & 1ull) != 0ull;
              if (wneed) { const bool rsel = ((selm[ql * 2 + (j >> 6)] >> (j & 63)) & 1ull) != 0ull;
                  const LAS unsigned char* kb = lds + L_K2 + buf * KBUF2 + sub * 64 * KS; const LAS unsigned char* vb = lds + L_V2 + buf * VBUF2 + sub * 64 * VS;
                  if (j == cur) att_step<true>(kb, vb, qr, m, l, ob0, ob1, 64 * j, 0, tq, rsel, r32, hi, lane);
                  else att_step<false>(kb, vb, qr, m, l, ob0, ob1, 64 * j, 0, tq, rsel, r32, hi, lane); } } } }
          if (dt + 1 < nd) tile2_store(lds, buf ^ 1, r2, tid);
          __syncthreads(); }
      int tidB_l = threadIdx.x; asm volatile("" : "+v"(tidB_l));
      const int laneB = tidB_l & 63, r32B = laneB & 31, widB = __builtin_amdgcn_readfirstlane(tidB_l >> 6), headB = 4 * g + (r32B & 3); const size_t qrowB = (size_t)b * SEQ + t0 + 8 * widB + (r32B >> 2);
      l = swap_sum(l); const float gt1 = gates[qrowB * 48 + headB * 3 + 1]; const float sc = l > 0.f ? gt1 / l : 0.f;
#pragma unroll
      for (int r = 0; r < 16; ++r) { const unsigned u = stash[64 * r]; stash[64 * r] = pk2(bf_lo(u) + sc * ob0[r], bf_hi(u) + sc * ob1[r]); ob0[r] = 0.f; ob1[r] = 0.f; }
      m = 0.f; l = 0.f; }
    int tidC_l = threadIdx.x; asm volatile("" : "+v"(tidC_l));
    const int tidC = tidC_l, laneC = tidC & 63, r32C = laneC & 31, hiC = laneC >> 5, widC = __builtin_amdgcn_readfirstlane(tidC >> 6), tqC = t0 + 8 * widC + (r32C >> 2), headC = 4 * g + (r32C & 3); const size_t qrowC = (size_t)b * SEQ + tqC;

    { const int jb = cur >= 8 ? cur - 8 : 0, d0 = jb >> 1, nd = (cur >> 1) - d0 + 1;
      r2 = tile2_load(Kw, Kw + 256, 128 * d0, tidC); tile2_store(lds, 0, r2, tidC);
      __syncthreads();
      for (int dt = 0; dt < nd; ++dt) { const int buf = dt & 1;
          if (dt + 1 < nd) r2 = tile2_load(Kw, Kw + 256, 128 * (d0 + dt + 1), tidC);
#pragma unroll
          for (int sub = 0; sub < 2; ++sub) { const int j = 2 * (d0 + dt) + sub;
              if (j >= jb && j <= cur) {
                  const LAS unsigned char* kb = lds + L_K2 + buf * KBUF2 + sub * 64 * KS; const LAS unsigned char* vb = lds + L_V2 + buf * VBUF2 + sub * 64 * VS;
                  if (j == jb || j == cur) att_step<true>(kb, vb, qr, m, l, ob0, ob1, 64 * j, tqC - 511, tqC, true, r32C, hiC, laneC);
                  else att_step<false>(kb, vb, qr, m, l, ob0, ob1, 64 * j, tqC - 511, tqC, true, r32C, hiC, laneC); } }
          if (dt + 1 < nd) tile2_store(lds, buf ^ 1, r2, tidC);
          __syncthreads(); } }
    { l = swap_sum(l); const float gt2 = gates[qrowC * 48 + headC * 3 + 2]; const float sc = l > 0.f ? gt2 / l : 0.f;
#pragma unroll
      for (int r = 0; r < 16; ++r) { const unsigned u = stash[64 * r]; ob0[r] = bf_lo(u) + sc * ob0[r]; ob1[r] = bf_hi(u) + sc * ob1[r]; } }
    { bf16* orow = O + qrowC * DM + headC * 64 + 4 * hiC;
#pragma unroll
      for (int gi = 0; gi < 4; ++gi) { v2u w; w.x = pk2(ob0[4 * gi], ob0[4 * gi + 1]); w.y = pk2(ob0[4 * gi + 2], ob0[4 * gi + 3]); *(v2u*)(orow + 8 * gi) = w;
          v2u w1; w1.x = pk2(ob1[4 * gi], ob1[4 * gi + 1]); w1.y = pk2(ob1[4 * gi + 2], ob1[4 * gi + 3]); *(v2u*)(orow + 32 + 8 * gi) = w1; } }
    __syncthreads();
}
}

namespace dec {
constexpr int L_SC = 1024, L_PC = 17408, L_RED = 19456, L_OBUF = 19584, L_OFIN = 27776, L_SBASE = 30848, L_NSEL = 30976;
constexpr float NEG = -1e30f;
__device__ __forceinline__ void block_reduce4(float (&v)[4], bool is_max, LAS float* red, int lane, int wave) {
#pragma unroll
    for (int h = 0; h < 4; ++h) v[h] = is_max ? wave_max(v[h]) : wave_sum(v[h]);
    __syncthreads();
    if (lane == 0) {
#pragma unroll
        for (int h = 0; h < 4; ++h) red[wave * 4 + h] = v[h]; }
    __syncthreads();
#pragma unroll
    for (int h = 0; h < 4; ++h) { float a = red[h];
#pragma unroll
        for (int w = 1; w < 8; ++w) a = is_max ? fmaxf(a, red[w * 4 + h]) : a + red[w * 4 + h];
        v[h] = a; }
}
__device__ __forceinline__ void softmax_sc(LAS float* sc, LAS float* red, float (&inv)[4], int tid, int lane, int wave) {
    float mx[4] = {NEG, NEG, NEG, NEG};
    for (int k = tid; k < 1024; k += 512) {
#pragma unroll
        for (int h = 0; h < 4; ++h) mx[h] = fmaxf(mx[h], sc[h * 1024 + k]); }
    block_reduce4(mx, true, red, lane, wave);
    float sm[4] = {0.f, 0.f, 0.f, 0.f};
    for (int k = tid; k < 1024; k += 512) {
#pragma unroll
        for (int h = 0; h < 4; ++h) { const float e = fast_exp2(sc[h * 1024 + k] - mx[h]); sc[h * 1024 + k] = e; sm[h] += e; } }
    block_reduce4(sm, false, red, lane, wave);
#pragma unroll
    for (int h = 0; h < 4; ++h) inv[h] = 1.f / sm[h];
}
struct LdCmp { const bf16* kc; const bf16* vc; int seq, g;
    __device__ __forceinline__ f32x4 operator()(int k, int which, int l16) const { const bf16* p = (which ? vc : kc) + ((size_t)(seq * 512 + k) * 4 + g) * 64 + 4 * l16; const v2u x = *(const v2u*)p; return (f32x4){bf_lo(x.x), bf_hi(x.x), bf_lo(x.y), bf_hi(x.y)}; } };
struct LdSel { const float* csel; const LAS long long* sbase; const float* newrow; int nk;
    __device__ __forceinline__ f32x4 operator()(int k, int which, int l16) const { const float* p = (k < nk - 1) ? csel + sbase[k >> 6] + (size_t)(k & 63) * 512 : newrow; return *(const f32x4*)(p + which * 256 + 4 * l16); } };
struct LdWin { const float* swin; const float* newrow; int seq, g;
    __device__ __forceinline__ f32x4 operator()(int k, int which, int l16) const { const float* p = (k < 511) ? swin + (size_t)(seq * 512 + k + 1) * 512 + g * 64 : newrow; return *(const f32x4*)(p + which * 256 + 4 * l16); } };
template <class Ld>
__device__ __forceinline__ void branch(const Ld& L, int nk, const f32x4 (&q)[4], LAS float* sc, LAS float* red, LAS float* obuf, LAS float* ofin, float (&inv)[4], int tid, int lane, int wave) {
    const int l16 = lane & 15, gq = lane >> 4, nsteps = (nk + 31) >> 5;
    for (int k = tid; k < 4096; k += 512) sc[k] = NEG;
    __syncthreads();
    for (int it0 = 0; it0 < nsteps; it0 += 8) { f32x4 kv[8];
#pragma unroll
        for (int j = 0; j < 8; ++j) { const int k = (it0 + j) * 32 + wave * 4 + gq; kv[j] = (k < nk) ? L(k, 0, l16) : (f32x4){0.f, 0.f, 0.f, 0.f}; }
#pragma unroll
        for (int j = 0; j < 8; ++j) { const int k = (it0 + j) * 32 + wave * 4 + gq; float s[4];
#pragma unroll
            for (int h = 0; h < 4; ++h) { float x = (kv[j].x * q[h].x + kv[j].y * q[h].y) + (kv[j].z * q[h].z + kv[j].w * q[h].w); s[h] = row16_sum(x); }
            if (k < nk && l16 < 4) sc[l16 * 1024 + k] = l16 == 0 ? s[0] : l16 == 1 ? s[1] : l16 == 2 ? s[2] : s[3]; } }
    __syncthreads();
    softmax_sc(sc, red, inv, tid, lane, wave);
    __syncthreads();
    f32x4 acc[4];
#pragma unroll
    for (int h = 0; h < 4; ++h) acc[h] = (f32x4){0.f, 0.f, 0.f, 0.f};
    for (int it0 = 0; it0 < nsteps; it0 += 8) { f32x4 vv[8];
#pragma unroll
        for (int j = 0; j < 8; ++j) { const int k = (it0 + j) * 32 + wave * 4 + gq; vv[j] = (k < nk) ? L(k, 1, l16) : (f32x4){0.f, 0.f, 0.f, 0.f}; }
#pragma unroll
        for (int j = 0; j < 8; ++j) { const int k = (it0 + j) * 32 + wave * 4 + gq; const int kc = k < 1024 ? k : 1023;
#pragma unroll
            for (int h = 0; h < 4; ++h) { const float p = (k < nk) ? sc[h * 1024 + kc] : 0.f; acc[h] += vv[j] * p; } } }
#pragma unroll
    for (int h = 0; h < 4; ++h)
#pragma unroll
        for (int e = 0; e < 4; ++e) { float x = acc[h][e]; x += __shfl_xor(x, 16); x += __shfl_xor(x, 32); acc[h][e] = x; }
    if (gq == 0) {
#pragma unroll
        for (int h = 0; h < 4; ++h) *(LAS f32x4*)(obuf + (wave * 4 + h) * 64 + 4 * l16) = acc[h]; }
    __syncthreads();
    if (tid < 256) { float a = 0.f;
#pragma unroll
        for (int w = 0; w < 8; ++w) a += obuf[w * 256 + tid];
        const int h = tid >> 6; ofin[tid] = a * (h == 0 ? inv[0] : h == 1 ? inv[1] : h == 2 ? inv[2] : inv[3]); }
    __syncthreads();
}
__device__ __forceinline__ void sample_attn_unit(const float* csel, const float* swin, const int* pt, unsigned char* ws, float* out, int seq, int g, LAS unsigned char* lds) {
    int tid_l = threadIdx.x; asm volatile("" : "+v"(tid_l)); const int tid = tid_l, lane = tid & 63, wave = tid >> 6, l16 = lane & 15;
    LAS float* sc = (LAS float*)(lds + L_SC); LAS float* Pc = (LAS float*)(lds + L_PC); LAS float* red = (LAS float*)(lds + L_RED);
    LAS float* obuf = (LAS float*)(lds + L_OBUF); LAS float* ofin = (LAS float*)(lds + L_OFIN); LAS long long* sbase = (LAS long long*)(lds + L_SBASE); LAS int* nselp = (LAS int*)(lds + L_NSEL);
    const float* QS = (const float*)(ws + WS_QS); const float* GS = (const float*)(ws + WS_GS);
    f32x4 q[4];
#pragma unroll
    for (int h = 0; h < 4; ++h) q[h] = *(const f32x4*)(QS + seq * DM + (4 * g + h) * 64 + 4 * l16);
    float inv[4];
    { const LdCmp L{(const bf16*)(ws + WS_KC), (const bf16*)(ws + WS_VC), seq, g}; branch(L, 511, q, sc, red, obuf, ofin, inv, tid, lane, wave); }
    Pc[tid] = tid < 511 ? (sc[tid] * inv[0] + sc[1024 + tid] * inv[1]) + (sc[2048 + tid] * inv[2] + sc[3072 + tid] * inv[3]) : 0.f;
    __syncthreads();
    if (wave == 0) { const int j0 = lane, j1 = lane + 64; const bool c0 = j0 >= 1, c1 = j1 <= 126;
        const float v0 = c0 ? Pc[4 * j0 - 1] + 2.f * (Pc[4 * j0] + Pc[4 * j0 + 1] + Pc[4 * j0 + 2]) + Pc[4 * j0 + 3] : 0.f;
        const float v1 = c1 ? Pc[4 * j1 - 1] + 2.f * (Pc[4 * j1] + Pc[4 * j1 + 1] + Pc[4 * j1 + 2]) + Pc[4 * j1 + 3] : 0.f;
        bool s0, s1; nsa::topk_select(c0, c1, __float_as_uint(v0), __float_as_uint(v1), 13, lane, s0, s1);
        s0 = s0 || j0 == 0; s1 = s1 || j1 == 127;
        unsigned long long b0 = __ballot(s0), b1 = __ballot(s1);
        if (lane == 0) { int n = 0;
            while (b0 && n < 15) { const int j = __builtin_ctzll(b0); b0 &= b0 - 1ull; sbase[n++] = ((long long)pt[seq * 64 + (j >> 1)] * 128 + (j & 1) * 64) * 512 + g * 64; }
            while (b1 && n < 15) { const int j = 64 + __builtin_ctzll(b1); b1 &= b1 - 1ull; sbase[n++] = ((long long)pt[seq * 64 + (j >> 1)] * 128 + (j & 1) * 64) * 512 + g * 64; }
            nselp[0] = n; } }
    __syncthreads();
    { const int nk = nselp[0] * 64 + 1; const LdSel L{csel, sbase, out + O_SELS + seq * 512 + g * 64, nk}; branch(L, nk, q, sc, red, obuf, ofin + 256, inv, tid, lane, wave); }
    { const LdWin L{swin, out + O_WINS + (size_t)(seq * 512 + 511) * 512 + g * 64, seq, g}; branch(L, 512, q, sc, red, obuf, ofin + 512, inv, tid, lane, wave); }
    if (tid < 256) { const int head = 4 * g + (tid >> 6); const float* gp = GS + seq * 48 + head * 3;
        const float o = gp[0] * ofin[tid] + gp[1] * ofin[256 + tid] + gp[2] * ofin[512 + tid];
        ((bf16*)(ws + WS_OS))[seq * DM + head * 64 + (tid & 63)] = (bf16)(pk2(o, 0.f) & 0xffffu); }
    __syncthreads();
}
}

#ifndef ONLY_SITE
#define ONLY_SITE -1
#endif
#define SITE_ON(n) (ONLY_SITE < 0 || ONLY_SITE == (n))
#ifndef PROBE_DUP
#define PROBE_DUP 0
#endif
#define REP(n) for (int rep_ = 0; rep_ < 1 + ((PROBE_DUP >> (n)) & 1); ++rep_)
__global__ void __launch_bounds__(NWAVES * 64, 2) yoco_fwd(Args args) {
    extern __shared__ __attribute__((aligned(16))) unsigned char lds_raw[];
    LAS unsigned char* const lds = (LAS unsigned char*)lds_raw;
    for (int u = threadIdx.x; u < (LDS_BYTES - LDSCTL_OFF) / 4; u += NWAVES * 64) ((LAS unsigned*)(lds + LDSCTL_OFF))[u] = 0u;
    __syncthreads();
    if (threadIdx.x == 0) { LAS unsigned long long* tab = (LAS unsigned long long*)(lds + PTAB_OFF);
#pragma unroll
        for (int i = 0; i < 28; ++i) tab[i] = (unsigned long long)args.in[i];
        tab[28] = (unsigned long long)args.out; tab[29] = (unsigned long long)args.ws; }
    __syncthreads();
    XcdBarrier bar; bar.bar = (unsigned*)((unsigned char*)tab_ptr(lds, 29) + WS_CTL) + CW_BAR; bar.x = 0; bar.st = nullptr;
    if (args.use_bar) bar = xcd_barrier_post(bar.bar, (volatile LAS unsigned*)(lds + MISC_OFF) + 8);
    const int lo = args.ph_lo, hi = args.ph_hi, use_bar = args.use_bar;
    int ph = 0;
#define PH_ON (ph >= lo && ph < hi)
#define PH_END do { if (PH_ON && ph + 1 < hi) { if (use_bar) xcd_barrier(bar); } ++ph; } while (0)
#define MKFRAME Frame F; F.lds = lds; F.MISC = (volatile LAS unsigned*)(lds + MISC_OFF); { int tid_l = threadIdx.x; asm volatile("" : "+v"(tid_l)); F.tid = tid_l; } F.lane = F.tid & 63; F.wave = __builtin_amdgcn_readfirstlane(F.tid >> 6); \
    F.G = gridDim.x; F.gw = blockIdx.x * NWAVES + F.wave; F.NGW = F.G * NWAVES; F.ws = (unsigned char*)tab_ptr(lds, 29); F.out = (float*)tab_ptr(lds, 28); unsigned char* const ws = F.ws; (void)ws

    if (SITE_ON(0) && PH_ON) REP(0) { MKFRAME; prologue_phase(F); }
    PH_END;

    for (int layer = 0; layer < 4; ++layer) {
        if (layer < 2) {
            if (SITE_ON(1) && PH_ON) REP(1) { MKFRAME;
                const bf16* W = (const bf16*)(ws + WS_WUV) + (size_t)layer * 2048 * 1024;
                pg8::Gemm g{(const bf16*)(ws + WS_XN), W, MP, 2048, DM}; pg8::StaticOrder S; S.init(MP, 2048, F.G, (int)blockIdx.x);
                EpiUV E{(bf16*)(ws + WS_U), (bf16*)(ws + WS_V), (float*)(ws + WS_ROWSS), (const float*)(ws + WS_ROWSS2)};
                pg8::gemm_phase<EpiUV, pg8::StaticOrder, true, true>(F.lds, g, S, E);
                SkUV SE{(float*)(ws + WS_USU), (float*)(ws + WS_VSF)};
                skinny_gemm_hs(F.lds, (const float*)(ws + WS_HS), W, 2048, SE);
            }
            PH_END;
            if (SITE_ON(2) && PH_ON) { MKFRAME;
#ifdef PROBE_GATE
                gating_phase(F, layer, (bf16*)(ws + WS_H1));
#endif
                gating_phase(F, layer, (bf16*)(ws + WS_U)); }
            PH_END;
        } else {
            if (SITE_ON(3) && PH_ON) REP(3) { MKFRAME;
                const bool first = layer == 2; const int N = first ? NKVQG : NQG1; const bf16* W = (const bf16*)(ws + (first ? WS_WKVQG : WS_WQG1));
                const float* bg = INF(22) + (layer - 2) * 48;
                pg8::Gemm g{(const bf16*)(ws + WS_XN), W, MP, N, DM}; pg8::StaticOrder S; S.init(MP, N, F.G, (int)blockIdx.x);
                EpiKVQG E{F.out, (bf16*)(ws + WS_ACMP), (bf16*)(ws + WS_KSEL), (bf16*)(ws + WS_KWIN), (bf16*)(ws + WS_Q), (float*)(ws + WS_GATES), bg, first ? 0 : 6, (const float*)(ws + WS_ROWSS2)};
                pg8::gemm_phase<EpiKVQG, pg8::StaticOrder, true, true>(F.lds, g, S, E);
                SkKVQG SE{F.out, (float*)(ws + WS_QS), (float*)(ws + WS_GS), bg, first ? 0 : 1536};
                skinny_gemm_hs(F.lds, (const float*)(ws + WS_HS), W, N, SE);
                if (first) {
                    pg8::Gemm g2{(const bf16*)(ws + WS_ACMP), (const bf16*)(ws + WS_WC1), 2 * ACMP_ROWS, 1024, DM};
                    TBEarlyOrder S2; S2.G = F.G; S2.c = (int)blockIdx.x;
                    EpiTB E2{(bf16*)(ws + WS_TB)};
                    pg8::gemm_phase<EpiTB, TBEarlyOrder, true, true>(F.lds, g2, S2, E2);
                }
            }
            PH_END;
            if (layer == 2) {
                if (SITE_ON(4) && PH_ON) REP(4) { MKFRAME;
                    pg8::Gemm g{(const bf16*)(ws + WS_ACMP), (const bf16*)(ws + WS_WC1F), 2 * ACMP_ROWS, 512, 2048};
                    TBFOrder S; S.G = F.G; S.c = (int)blockIdx.x; S.HB = (const bf16*)(ws + WS_HB); S.W2 = (const bf16*)(ws + WS_WC2); S.KC = (bf16*)(ws + WS_KC); S.VC = (bf16*)(ws + WS_VC);
                    EpiH E{(bf16*)(ws + WS_HB), (const float*)(ws + WS_BIAS1)};
                    pg8::gemm_phase<EpiH, TBFOrder, true, true, 1024, 8192>(F.lds, g, S, E);
                    for (int x = F.gw; x < 512; x += F.NGW) { const int kv = x >> 8, un = 3840 + (x & 255);
                        combine16_tb((const bf16*)(ws + WS_TB + (size_t)kv * WS_TB_STRIDE), (const float*)(ws + WS_BIAS1) + kv * 256, (const bf16*)(ws + WS_WC2) + (size_t)kv * 64 * 256, (bf16*)(ws + (kv ? WS_VC : WS_KC)), un, F.lane); }
                }
                PH_END;
            }
            if (SITE_ON(6) && PH_ON) REP(6) { MKFRAME;
                const bf16* kcp = (const bf16*)(ws + WS_KC) + (size_t)65536 * 64; const bf16* vcp = (const bf16*)(ws + WS_VC) + (size_t)65536 * 64;
                for (int un = blockIdx.x; un < 1024; un += F.G) { const int bx = un & 255, v = (bx & 7) * 32 + (bx >> 3), i = un >> 8, bg = v >> 5, s = v & 31;
                    const int qb = NSA_QB[s * 4 + i];
                    nsa::nsa_unit((const bf16*)(ws + WS_Q), (const float*)(ws + WS_GATES), kcp, vcp, (const bf16*)(ws + WS_KSEL), (const bf16*)(ws + WS_KWIN), (bf16*)(ws + WS_OATT), bg >> 2, bg & 3, qb, F.lds); }
                const float* csel = INF(3); const float* swin = INF(4); const int* pt = (const int*)tab_ptr(lds, 5);
#ifndef PROBE_DEC
#define PROBE_DEC 1
#endif
                for (int rp_ = 0; rp_ < PROBE_DEC; ++rp_)
                for (int un = blockIdx.x; un < NS * 4; un += F.G) dec::sample_attn_unit(csel, swin, pt, ws, F.out, un >> 2, un & 3, F.lds);
            }
            PH_END;
        }
        if (SITE_ON(7) && PH_ON) { MKFRAME;
            const bf16* A = (const bf16*)(ws + (layer < 2 ? WS_U : WS_OATT)); const bf16* W = (layer < 2) ? (const bf16*)(ws + WS_WAO) + (size_t)layer * 1024 * 1024 : (const bf16*)(ws + WS_WBO) + (size_t)(layer - 2) * 1024 * 1024;
            pg8::Gemm g{A, W, MP, DM, DM}; pg8::StaticOrder S; S.init(MP, DM, F.G, (int)blockIdx.x);
            EpiResid E{(bf16*)(ws + WS_XN), (float*)(ws + WS_ROWSS2)};
            pg8::gemm_phase<EpiResid, pg8::StaticOrder, true, true>(F.lds, g, S, E);
            SkResid SE{(float*)(ws + WS_HS)};
            skinny_gemm(F.lds, (const bf16*)(ws + (layer < 2 ? WS_USS : WS_OS)), W, DM, DM, SE);
        }
        PH_END;
        if (SITE_ON(9) && PH_ON) REP(9) { MKFRAME;
            const bf16* W = (const bf16*)(ws + WS_WUP) + (size_t)layer * 4096 * 1024;
            pg8::Gemm g{(const bf16*)(ws + WS_XN), W, MP, FF, DM}; pg8::StaticOrder S; S.init(MP, FF, F.G, (int)blockIdx.x);
            EpiSqRelu E{(bf16*)(ws + WS_H1), FF, (const float*)(ws + WS_ROWSS2)};
            pg8::gemm_phase<EpiSqRelu, pg8::StaticOrder, true, true>(F.lds, g, S, E);
            SkSqRelu SE{(bf16*)(ws + WS_H1S)};
            skinny_gemm_hs(F.lds, (const float*)(ws + WS_HS), W, FF, SE);
        }
        PH_END;
        if (SITE_ON(10) && PH_ON) { MKFRAME;
            const bf16* W = (const bf16*)(ws + WS_WDN) + (size_t)layer * 1024 * 4096;
            pg8::Gemm g{(const bf16*)(ws + WS_H1), W, MP, DM, FF}; pg8::StaticOrder S; S.init(MP, DM, F.G, (int)blockIdx.x);
            EpiResid E{(bf16*)(ws + WS_XN), (float*)(ws + WS_ROWSS2)};
            pg8::gemm_phase<EpiResid, pg8::StaticOrder, true, true>(F.lds, g, S, E);
            SkResid SE{(float*)(ws + WS_HS)};
            skinny_gemm(F.lds, (const bf16*)(ws + WS_H1S), W, FF, DM, SE);
        }
        PH_END;
        if (layer == 3) {
            if (SITE_ON(11) && PH_ON) { MKFRAME;
                float* HP = F.out + O_Y; const float* fg = INF(27); const float* HS = (const float*)(ws + WS_HS);
                for (int m = F.gw; m < MP + NS; m += F.NGW) {
                    if (m < MP) norm_row_bf16((const bf16*)(ws + WS_XN) + (size_t)m * DM, (const float*)(ws + WS_ROWSS2) + (size_t)m * 16, fg, HP + (size_t)m * DM, F.lane);
                    else norm_row_f32(HS + (size_t)(m - MP) * DM, fg, F.out + O_YS + (size_t)(m - MP) * DM, F.lane); }
            }
            PH_END;
        }
    }
#undef PH_ON
#undef PH_END
#undef MKFRAME
}
constexpr int N_PHASES = 1 + 2 * 5 + 6 + 5 + 1;

extern "C" void kernel_launch(void* const* d_in, const int* in_sizes, int n_in, void* d_out, int out_size, void* d_ws, size_t ws_size, hipStream_t stream) {
    static int grid = 0;
    if (grid == 0) {
        if (n_in != 28 || (size_t)out_size != O_END || ws_size < WS_END) { fprintf(stderr, "kernel_launch: unexpected shapes (n_in %d, out %d, ws %zu); nothing launched\n", n_in, out_size, ws_size); grid = -1; return; }
        int dev = 0, cus = 0, per_cu = 0;
        if (hipGetDevice(&dev) != hipSuccess || hipDeviceGetAttribute(&cus, hipDeviceAttributeMultiprocessorCount, dev) != hipSuccess) { grid = -1; return; }
        if (hipFuncSetAttribute((const void*)yoco_fwd, hipFuncAttributeMaxDynamicSharedMemorySize, LDS_BYTES) != hipSuccess) { fprintf(stderr, "kernel_launch: hipFuncSetAttribute failed\n"); grid = -1; return; }
        if (hipOccupancyMaxActiveBlocksPerMultiprocessor(&per_cu, (const void*)yoco_fwd, NWAVES * 64, LDS_BYTES) != hipSuccess || per_cu < 1) { fprintf(stderr, "kernel_launch: occupancy query reports %d blocks per CU\n", per_cu); }
        (void)hipGetLastError();
        grid = cus;
    }
    if (grid < 0) return;
    if (hipMemsetAsync((char*)d_ws + WS_CTL, 0, CTL_ZERO_BYTES, stream) != hipSuccess) return;
    Args a{};
    for (int i = 0; i < 28; ++i) a.in[i] = d_in[i];
    a.out = (float*)d_out; a.ws = (unsigned char*)d_ws; a.pad = 0;
#if MK_PER_PHASE
    for (int p = 0; p < N_PHASES; ++p) { a.ph_lo = p; a.ph_hi = p + 1; a.use_bar = 0; hipLaunchKernelGGL(yoco_fwd, dim3(grid), dim3(NWAVES * 64), LDS_BYTES, stream, a); }
#else
    a.ph_lo = 0; a.ph_hi = N_PHASES; a.use_bar = 1;
    hipLaunchKernelGGL(yoco_fwd, dim3(grid), dim3(NWAVES * 64), LDS_BYTES, stream, a);
#endif
    const hipError_t le = hipPeekAtLastError();
    if (le != hipSuccess) fprintf(stderr, "kernel_launch: launch failed: %s\n", hipGetErrorName(le));
}
```

```cpp
#include <hip/hip_runtime.h>
#include <cstdio>
#include <cstdint>
#ifndef MK_PER_PHASE
#define MK_PER_PHASE 0
#endif
namespace pg8 {
#define PG8_LAS __attribute__((address_space(3)))
typedef unsigned short bf16_t;
typedef short bf16x8 __attribute__((ext_vector_type(8)));
typedef float f32x4 __attribute__((ext_vector_type(4)));
typedef unsigned u32x4 __attribute__((ext_vector_type(4)));
constexpr int BM = 256, BK = 64, HALF = 128, HTB = HALF * BK * 2  , STAGE_BYTES = 8 * HTB, NXCD = 8, WGM = 8;

__host__ __device__ __forceinline__ int lds_byte(int r, int c) { const int st = (r >> 4) * 2 + (c >> 5), rr = r & 15, cc = c & 31, ob = rr * 64 + cc * 2; return st * 1024 + (ob ^ (((ob >> 9) & 1) << 5)); }
__host__ __device__ __forceinline__ void stage_rc(int b, int& R, int& C) { const int st = b / 1024, sb = b % 1024, swz = sb ^ (((sb >> 9) & 1) << 5); R = (st >> 1) * 16 + swz / 64; C = (st & 1) * 32 + (swz % 64) / 2; }
__host__ __device__ __forceinline__ int perm32(int rho) { const int n = rho >> 4, i = rho & 15; return 8 * (i >> 2) + 4 * n + (i & 3); }

struct Unit { int pm, pn; };
struct Gemm { const bf16_t* A; const bf16_t* Bt; int M, N, K; };

struct StaticOrder {
    int nM, nN, nwg, G, c;
    __host__ __device__ void init(int M, int N, int G_, int c_) { nM = M / BM; nN = N / BM; nwg = nM * nN; G = G_; c = c_; }
    __host__ __device__ bool next(int i, Unit& u) const {
        const long L = (long)i * G + c; if (L >= nwg) return false;
        int wgid = (int)L; { const int q = nwg / NXCD, r = nwg % NXCD, xcd = wgid % NXCD, off = wgid / NXCD; wgid = (xcd < r ? xcd * (q + 1) : r * (q + 1) + (xcd - r) * q) + off; }
        const int nig = WGM * nN, gid = wgid / nig, fm = gid * WGM, gsz = (nM - fm) < WGM ? (nM - fm) : WGM;
        u.pm = fm + ((wgid % nig) % gsz); u.pn = (wgid % nig) / gsz; return true;
    }
    __device__ __forceinline__ void a_ready(const Unit&) const {}
    __device__ __forceinline__ void done(const Unit&) const {}
};

}
namespace pg8 {
template <class Epi, class Sched, bool ALIGN_EPI = false, bool SP2 = false, int LDA = 0, int AJ = 0>
__device__ __forceinline__ void gemm_phase(PG8_LAS unsigned char* lds, const Gemm g, const Sched& S, const Epi& E) {
    int tid_l = threadIdx.x; asm volatile("" : "+v"(tid_l)); const int tid = tid_l, wid = __builtin_amdgcn_readfirstlane(tid >> 6), lane = tid & 63, wr = wid >> 2, wc = wid & 3, fr = lane & 15, fq = lane >> 4;
    const int K = g.K, nt = K / BK;
    unsigned voffA[2], voffB[2];
#pragma unroll
    for (int i = 0; i < 2; ++i) { int R, C; stage_rc(tid * 16 + i * 8192, R, C); const int Rb = Epi::PERM ? ((R & ~31) + perm32(R & 31)) : R;
        voffA[i] = (unsigned)(R * (LDA ? LDA : K) + C) * 2u; voffB[i] = (unsigned)(Rb * K + C) * 2u; }
    const size_t kstep = (size_t)(BK * 2);
    const size_t hstep = (size_t)HALF * K * 2;
    const size_t tstep = 2 * hstep;
    const size_t hstepA = LDA ? (size_t)HALF * LDA * 2 : hstep, tstepA = 2 * hstepA;
    const size_t ks1 = AJ ? (size_t)AJ : kstep, ks2 = AJ ? kstep : 2 * kstep;
    const unsigned ldsw = (unsigned)wid * 1024u;
    const int aoff = lds_byte(wr * 64 + fr, fq * 8), boff = lds_byte(wc * 32 + fr, fq * 8);
#define PG8_SA(b, h) (((b) * 2 + (h)) * HTB)
#define PG8_SB(b, h) ((4 + (b) * 2 + (h)) * HTB)
#define PG8_STAGE(bufoff, gbase, voff) do { _Pragma("unroll") for (int _i = 0; _i < 2; ++_i) \
        __builtin_amdgcn_global_load_lds((const unsigned*)((const char*)(gbase) + (voff)[_i]), (PG8_LAS unsigned*)(lds + (bufoff) + ldsw + _i * 8192), 16, 0, 0); } while (0)
#define PG8_LDA(dst, b, h) do { _Pragma("unroll") for (int m = 0; m < 4; ++m) _Pragma("unroll") for (int k = 0; k < 2; ++k) dst[m][k] = *(const PG8_LAS bf16x8*)(lds + PG8_SA(b, h) + aoff + m * 2048 + k * 1024); } while (0)
#define PG8_LDB(dst, b, h) do { _Pragma("unroll") for (int n = 0; n < 2; ++n) _Pragma("unroll") for (int k = 0; k < 2; ++k) dst[n][k] = *(const PG8_LAS bf16x8*)(lds + PG8_SB(b, h) + boff + n * 2048 + k * 1024); } while (0)
#define PG8_MMA(ai, bj, At, Bt) do { __builtin_amdgcn_s_setprio(1); _Pragma("unroll") for (int m = 0; m < 4; ++m) _Pragma("unroll") for (int n = 0; n < 2; ++n) _Pragma("unroll") for (int k = 0; k < 2; ++k) \
        acc[ai][bj][m][n] = __builtin_amdgcn_mfma_f32_16x16x32_bf16(Bt[n][k], At[m][k], acc[ai][bj][m][n], 0, 0, 0); __builtin_amdgcn_s_setprio(0); } while (0)
#define PG8_WAIT_V(n) asm volatile("s_waitcnt vmcnt(" #n ")" ::: "memory")
#define PG8_WAIT_L(n) asm volatile("s_waitcnt lgkmcnt(" #n ")" ::: "memory")
#define PG8_BAR __builtin_amdgcn_s_barrier()
#define PG8_SCHED __builtin_amdgcn_sched_barrier(0)
    Unit cur, nxt; int ui = 0;
    if (!S.next(0, cur)) return;
    f32x4 acc[2][2][4][2];
#pragma unroll
    for (int a = 0; a < 2; ++a)
#pragma unroll
        for (int b = 0; b < 2; ++b)
#pragma unroll
            for (int m = 0; m < 4; ++m)
#pragma unroll
                for (int n = 0; n < 2; ++n) acc[a][b][m][n] = (f32x4){0.f, 0.f, 0.f, 0.f};
    bf16x8 At[4][2], B0[2][2], B1[2][2];
    const char* cA = (const char*)g.A + (size_t)cur.pm * tstepA; const char* cB = (const char*)g.Bt + (size_t)cur.pn * tstep;
    S.a_ready(cur);
    if constexpr (SP2) {
        PG8_STAGE(PG8_SB(0, 0), cB, voffB); PG8_STAGE(PG8_SB(0, 1), cB + hstep, voffB); PG8_STAGE(PG8_SA(0, 0), cA, voffA); PG8_STAGE(PG8_SA(0, 1), cA + hstepA, voffA);
        if (wr == 1) PG8_BAR;
        PG8_WAIT_V(2); PG8_BAR;
        PG8_STAGE(PG8_SB(1, 0), cB + kstep, voffB); PG8_STAGE(PG8_SA(1, 0), cA + ks1, voffA); PG8_STAGE(PG8_SB(1, 1), cB + hstep + kstep, voffB);
        PG8_WAIT_V(6); PG8_BAR;
    } else {
        PG8_STAGE(PG8_SB(0, 0), cB, voffB); PG8_STAGE(PG8_SA(0, 0), cA, voffA); PG8_STAGE(PG8_SB(0, 1), cB + hstep, voffB); PG8_STAGE(PG8_SA(0, 1), cA + hstepA, voffA);
        if (wr == 1) PG8_BAR;
        PG8_WAIT_V(4); PG8_BAR;
        PG8_STAGE(PG8_SB(1, 0), cB + kstep, voffB); PG8_STAGE(PG8_SA(1, 0), cA + ks1, voffA); PG8_STAGE(PG8_SB(1, 1), cB + hstep + kstep, voffB);
        PG8_WAIT_V(6); PG8_BAR;
    }
    for (;;) {
        const bool has_next = S.next(ui + 1, nxt);
        const char* nA = has_next ? (const char*)g.A + (size_t)nxt.pm * tstepA : cA; const char* nB = has_next ? (const char*)g.Bt + (size_t)nxt.pn * tstep : cB;
        for (int t = 0; t < nt; t += 2) {
            const bool last = (t == nt - 2);
            const char* a1 = cA + (size_t)(t >> 1) * ks2 + ks1;
            const char* a2 = last ? nA : cA + (size_t)((t >> 1) + 1) * ks2; const char* b2 = last ? nB : cB + (size_t)(t + 2) * kstep;
            const char* a3 = a2 + ks1; const char* b3 = b2 + kstep;
            if (last && has_next) S.a_ready(nxt);
            if constexpr (SP2) {
            PG8_LDB(B0, 0, 0); PG8_LDB(B1, 0, 1); PG8_SCHED; PG8_LDA(At, 0, 0); PG8_STAGE(PG8_SA(1, 1), a1 + hstepA, voffA);
            PG8_WAIT_V(8); PG8_WAIT_L(0); PG8_BAR; PG8_MMA(0, 0, At, B0); PG8_MMA(0, 1, At, B1); PG8_BAR; PG8_SCHED;
            PG8_LDA(At, 0, 1); PG8_STAGE(PG8_SB(0, 0), b2, voffB); PG8_STAGE(PG8_SB(0, 1), b2 + hstep, voffB); PG8_STAGE(PG8_SA(0, 0), a2, voffA);
            PG8_WAIT_V(8); PG8_WAIT_L(0); PG8_BAR; PG8_MMA(1, 0, At, B0); PG8_MMA(1, 1, At, B1); PG8_BAR; PG8_SCHED;
            PG8_LDB(B0, 1, 0); PG8_LDB(B1, 1, 1); PG8_SCHED; PG8_LDA(At, 1, 0); PG8_STAGE(PG8_SA(0, 1), a2 + hstepA, voffA);
            PG8_WAIT_V(8); PG8_WAIT_L(0); PG8_BAR; PG8_MMA(0, 0, At, B0); PG8_MMA(0, 1, At, B1); PG8_BAR; PG8_SCHED;
            PG8_LDA(At, 1, 1); PG8_STAGE(PG8_SB(1, 0), b3, voffB); PG8_STAGE(PG8_SB(1, 1), b3 + hstep, voffB); PG8_STAGE(PG8_SA(1, 0), a3, voffA);
            PG8_WAIT_V(8); PG8_WAIT_L(0); PG8_BAR; PG8_MMA(1, 0, At, B0); PG8_MMA(1, 1, At, B1); PG8_BAR; PG8_SCHED;
            } else {
            PG8_LDB(B0, 0, 0); PG8_SCHED; PG8_LDA(At, 0, 0); PG8_STAGE(PG8_SA(1, 1), a1 + hstepA, voffA);
            PG8_WAIT_L(8); PG8_BAR; PG8_WAIT_L(0); PG8_MMA(0, 0, At, B0); PG8_BAR; PG8_SCHED;
            PG8_LDB(B1, 0, 1); PG8_STAGE(PG8_SB(0, 0), b2, voffB);
            PG8_BAR; PG8_WAIT_L(0); PG8_MMA(0, 1, At, B1); PG8_BAR;
            PG8_LDA(At, 0, 1); PG8_STAGE(PG8_SA(0, 0), a2, voffA);
            PG8_BAR; PG8_WAIT_L(0); PG8_MMA(1, 0, At, B0); PG8_BAR; PG8_SCHED;
            PG8_STAGE(PG8_SB(0, 1), b2 + hstep, voffB);
            PG8_WAIT_V(6); PG8_BAR; PG8_MMA(1, 1, At, B1); PG8_BAR;
            PG8_LDB(B0, 1, 0); PG8_SCHED; PG8_LDA(At, 1, 0); PG8_STAGE(PG8_SA(0, 1), a2 + hstepA, voffA);
            PG8_WAIT_L(8); PG8_BAR; PG8_WAIT_L(0); PG8_MMA(0, 0, At, B0); PG8_BAR; PG8_SCHED;
            PG8_LDB(B1, 1, 1); PG8_STAGE(PG8_SB(1, 0), b3, voffB);
            PG8_BAR; PG8_WAIT_L(0); PG8_MMA(0, 1, At, B1); PG8_BAR;
            PG8_LDA(At, 1, 1); PG8_STAGE(PG8_SA(1, 0), a3, voffA);
            PG8_BAR; PG8_WAIT_L(0); PG8_MMA(1, 0, At, B0); PG8_BAR; PG8_SCHED;
            PG8_STAGE(PG8_SB(1, 1), b3 + hstep, voffB);
            PG8_WAIT_V(6); PG8_BAR; PG8_MMA(1, 1, At, B1); PG8_BAR;
            }
        }
        if constexpr (ALIGN_EPI) { if (wr == 0) PG8_BAR; }
        if constexpr (!Epi::AFTER_DRAIN) { E(acc, cur, wr, wc, fr, fq); S.done(cur); }
        if (!has_next) break;
#pragma unroll
        for (int a = 0; a < 2; ++a)
#pragma unroll
            for (int b = 0; b < 2; ++b)
#pragma unroll
                for (int m = 0; m < 4; ++m)
#pragma unroll
                    for (int n = 0; n < 2; ++n) acc[a][b][m][n] = (f32x4){0.f, 0.f, 0.f, 0.f};
        cur = nxt; cA = nA; cB = nB; ++ui;
        if constexpr (ALIGN_EPI) { if (wr == 1) PG8_BAR; }
    }
    PG8_WAIT_V(0);
    if constexpr (!ALIGN_EPI) { if (wr == 0) PG8_BAR; }
    PG8_BAR;
    if constexpr (Epi::AFTER_DRAIN) { E.fused(acc, cur, wr, wc, fr, fq, lds, wid, lane); S.done(cur); }
#undef PG8_SA
#undef PG8_SB
#undef PG8_STAGE
#undef PG8_LDA
#undef PG8_LDB
#undef PG8_MMA
#undef PG8_WAIT_V
#undef PG8_WAIT_L
#undef PG8_BAR
#undef PG8_SCHED
}
}
#define LAS __attribute__((address_space(3)))
#define XB_TMO      128
#define XB_XCNT(j)  (256  + 64 * (j))
#define XB_XSUB(j)  (1280 + 64 * (j))
#define XB_XGEN(j)  (2304 + 64 * (j))
#define XB_TOP      3328
#define XB_TOPGEN   3392
#define XCD_BAR_WORDS 3456
#define XB_SPIN_CAP (1u << 18)

__device__ __forceinline__ unsigned xb_ld(unsigned* p)              { return __hip_atomic_load(p, __ATOMIC_RELAXED, __HIP_MEMORY_SCOPE_AGENT); }
__device__ __forceinline__ unsigned xb_add(unsigned* p, unsigned v) { return __hip_atomic_fetch_add(p, v, __ATOMIC_RELAXED, __HIP_MEMORY_SCOPE_AGENT); }
__device__ __forceinline__ unsigned xb_xcc_id() { return (unsigned)__builtin_amdgcn_s_getreg((3 << 11) | 20) & 0xFu; }
#define XB_SPIN(cond, bar) do { unsigned _sp = 0; while (cond) { __builtin_amdgcn_s_sleep(1); \
    if ((++_sp & 255u) == 0u) { if (xb_ld(&(bar)[XB_TMO])) break; if (_sp > XB_SPIN_CAP) { atomicAdd(&(bar)[XB_TMO], 1u); break; } } } } while (0)

struct XcdBarrier {
    unsigned* bar; unsigned x;
    volatile LAS unsigned* st;
};

__device__ __forceinline__ XcdBarrier xcd_barrier_post(unsigned* bar, volatile LAS unsigned* st) {
    XcdBarrier b; b.bar = bar; b.x = xb_xcc_id(); b.st = st;
    if (threadIdx.x == 0) (void)xb_add(&bar[XB_XCNT(b.x)], 1u);
    return b;
}
__device__ __forceinline__ void xcd_barrier_complete(unsigned* bar, unsigned x, unsigned& nloc, unsigned& nx) {
    const unsigned G = gridDim.x * gridDim.y * gridDim.z;
    unsigned sum, cnt, mine, sp = 0u;
    for (;;) {
        sum = 0u; cnt = 0u; mine = 0u;
#pragma unroll
        for (unsigned j = 0; j < 16; ++j) { const unsigned c = xb_ld(&bar[XB_XCNT(j)]); sum += c; cnt += (c > 0u) ? 1u : 0u; mine = (j == x) ? c : mine; }
        if (sum == G) break;
        __builtin_amdgcn_s_sleep(1);
        if ((++sp & 255u) == 0u) { if (xb_ld(&bar[XB_TMO])) break; if (sp > XB_SPIN_CAP) { atomicAdd(&bar[XB_TMO], 1u); break; } }
    }
    nloc = mine > 0u ? mine : 1u; nx = cnt > 0u ? cnt : 1u;
}

__device__ __forceinline__ void xcd_barrier(const XcdBarrier& b) {
    asm volatile("s_waitcnt vmcnt(0)" ::: "memory");
    __syncthreads();
    if (threadIdx.x == 0) {
        unsigned* bar = b.bar;
        __builtin_amdgcn_s_waitcnt(0);
        unsigned nloc = b.st[0], nx = b.st[1];
        if (nloc == 0u) { xcd_barrier_complete(bar, b.x, nloc, nx); b.st[0] = nloc; b.st[1] = nx; }
        const unsigned old = xb_add(&bar[XB_XSUB(b.x)], 1u);
        const unsigned gen = old / nloc;
        if (old + 1u == (gen + 1u) * nloc) {
            __builtin_amdgcn_fence(__ATOMIC_RELEASE, "agent");
            asm volatile("s_waitcnt vmcnt(0)" ::: "memory");
            const unsigned og = xb_add(&bar[XB_TOP], 1u);
            const unsigned tg = og / nx;
            if (og + 1u == (tg + 1u) * nx) xb_add(&bar[XB_TOPGEN], 1u);
            else XB_SPIN(xb_ld(&bar[XB_TOPGEN]) == tg, bar);
            __builtin_amdgcn_fence(__ATOMIC_ACQUIRE, "agent");
            xb_add(&bar[XB_XGEN(b.x)], 1u);
            asm volatile("s_waitcnt vmcnt(0)" ::: "memory");
        } else {
            XB_SPIN(xb_ld(&bar[XB_XGEN(b.x)]) == gen, bar);
            __builtin_amdgcn_fence(__ATOMIC_ACQUIRE, "agent");
            asm volatile("s_waitcnt vmcnt(0)" ::: "memory");
        }
    }
    __syncthreads();
}

#define GAS __attribute__((address_space(1)))
typedef unsigned short bf16;
typedef unsigned v4u __attribute__((ext_vector_type(4)));
typedef unsigned v2u __attribute__((ext_vector_type(2)));
typedef float f32x4 __attribute__((ext_vector_type(4)));
typedef float f32x2 __attribute__((ext_vector_type(2)));
typedef float f32x16 __attribute__((ext_vector_type(16)));
typedef short bf16x8 __attribute__((ext_vector_type(8)));
typedef short s16x4 __attribute__((ext_vector_type(4)));
typedef __bf16 bf16x2_t __attribute__((ext_vector_type(2)));
#define LDS_WAIT() asm volatile("s_waitcnt lgkmcnt(0)" ::: "memory")
#define VM_WAIT() asm volatile("s_waitcnt vmcnt(0)" ::: "memory")

__device__ __forceinline__ unsigned pk2(float lo, float hi) { f32x2 v = {lo, hi}; bf16x2_t b = __builtin_convertvector(v, bf16x2_t); return __builtin_bit_cast(unsigned, b); }
__device__ __forceinline__ float bf_lo(unsigned u) { return __uint_as_float(u << 16); }
__device__ __forceinline__ float bf_hi(unsigned u) { return __uint_as_float(u & 0xffff0000u); }
__device__ __forceinline__ float bf1(bf16 h) { return __uint_as_float(((unsigned)h) << 16); }
__device__ __forceinline__ float wave_sum(float v) {
#pragma unroll
    for (int o = 1; o < 64; o <<= 1) v += __shfl_xor(v, o);
    return v;
}
__device__ __forceinline__ float wave_max(float v) {
#pragma unroll
    for (int o = 1; o < 64; o <<= 1) v = fmaxf(v, __shfl_xor(v, o));
    return v;
}
__device__ __forceinline__ float swap_max(float m) { auto rr = __builtin_amdgcn_permlane32_swap(__float_as_uint(m), __float_as_uint(m), false, false); return fmaxf(__uint_as_float(rr[0]), __uint_as_float(rr[1])); }
__device__ __forceinline__ float swap_sum(float m) { auto rr = __builtin_amdgcn_permlane32_swap(__float_as_uint(m), __float_as_uint(m), false, false); return __uint_as_float(rr[0]) + __uint_as_float(rr[1]); }
__device__ __forceinline__ float fast_exp2(float x) { return __builtin_amdgcn_exp2f(x); }
__device__ __forceinline__ float quad_sum(float x) {
    float y = x + __int_as_float(__builtin_amdgcn_update_dpp(0, __float_as_int(x), 0xB1, 0xF, 0xF, true));
    return y + __int_as_float(__builtin_amdgcn_update_dpp(0, __float_as_int(y), 0x4E, 0xF, 0xF, true));
}
__device__ __forceinline__ float row16_sum(float x) {
    float y = quad_sum(x);
    y += __int_as_float(__builtin_amdgcn_update_dpp(0, __float_as_int(y), 0x124, 0xF, 0xF, true));
    return y + __int_as_float(__builtin_amdgcn_update_dpp(0, __float_as_int(y), 0x128, 0xF, 0xF, true));
}

constexpr int DM = 1024, SEQ = 8192, MP = 2 * SEQ, NS = 32, FF = 4096;
constexpr float EPS = 1e-6f;
constexpr float C2 = 0.125f * 1.4426950408889634f;
constexpr int NKVQG = 2816, NQG1 = 1280;
constexpr int ACMP_ROWS = 69632;
constexpr size_t O_Y = 0, O_YS = 16777216, O_CMP = 16809984, O_SEL = 25198592, O_WIN = 33587200, O_CMPS = 34111488, O_SELS = 34127872, O_WINS = 34144256, O_AV = 42532864, O_END = 42598400;

constexpr size_t MiB = 1u << 20;
constexpr size_t WS_CTL = 0, CTL_ZERO_BYTES = 1 * MiB;
constexpr size_t WS_WUV = 2 * MiB, WS_WAO = 10 * MiB, WS_WSB = 14 * MiB, WS_WKVQG = 15 * MiB, WS_WQG1 = 21 * MiB, WS_WBO = 24 * MiB, WS_WUP = 28 * MiB, WS_WDN = 60 * MiB, WS_WC1 = 92 * MiB, WS_WC2 = 94 * MiB;
constexpr size_t WS_BIAS1 = 94 * MiB + 512 * 1024;
constexpr size_t WS_ROWSS2 = 194 * MiB;
constexpr size_t WS_XN = 96 * MiB, WS_U = 128 * MiB, WS_V = 160 * MiB, WS_ROWSS = 192 * MiB, WS_H1 = 200 * MiB, WS_KSEL = 328 * MiB, WS_KWIN = 344 * MiB, WS_Q = 360 * MiB, WS_GATES = 392 * MiB, WS_OATT = 396 * MiB;
constexpr size_t WS_ACMP = 428 * MiB, WS_TB = 700 * MiB, WS_TB_STRIDE = 70 * MiB, WS_KC = 840 * MiB, WS_VC = 850 * MiB;
constexpr size_t WS_SMP = 860 * MiB, SMP_SLOT = 256 * 1024;
constexpr size_t WS_XNS = WS_SMP, WS_USU = WS_SMP + 1 * SMP_SLOT, WS_VSF = WS_SMP + 2 * SMP_SLOT, WS_USS = WS_SMP + 3 * SMP_SLOT, WS_H1S = WS_SMP + 4 * SMP_SLOT, WS_QS = WS_SMP + 5 * SMP_SLOT, WS_GS = WS_SMP + 6 * SMP_SLOT, WS_OS = WS_SMP + 7 * SMP_SLOT, WS_HS = WS_SMP + 8 * SMP_SLOT;
constexpr size_t WS_HB = 864 * MiB;
constexpr size_t WS_WC1F = 932 * MiB;
constexpr size_t WS_END = 936 * MiB;
constexpr int CW_BAR = 4096;

constexpr int RING_BYTES = 131072, LDS_BYTES = 147456, LDSCTL_OFF = LDS_BYTES - 2048, MISC_OFF = LDSCTL_OFF + 320;
constexpr int NWAVES = 8;

struct Args { const void* in[28]; float* out; unsigned char* ws; int ph_lo, ph_hi, use_bar, pad; };

__device__ __forceinline__ void rows_rstd(const float* rs, int row0, int fq, float (&r)[2][4]) {
    pg8::f32x4 p[2][4];
#pragma unroll
    for (int ai = 0; ai < 2; ++ai)
#pragma unroll
        for (int m = 0; m < 4; ++m) p[ai][m] = *(const pg8::f32x4*)(rs + (size_t)(row0 + ai * 128 + m * 16) * 16 + 4 * fq);
#pragma unroll
    for (int ai = 0; ai < 2; ++ai)
#pragma unroll
        for (int m = 0; m < 4; ++m) { float t = (p[ai][m][0] + p[ai][m][1]) + (p[ai][m][2] + p[ai][m][3]); t += __shfl_xor(t, 16); t += __shfl_xor(t, 32); r[ai][m] = rsqrtf(t * (1.f / DM) + EPS); }
}
constexpr int RSTD_CACHE_OFF = RING_BYTES + 4096;
__device__ __forceinline__ void rows_rstd_cached(const float* rs, int pm, int& last_pm, int row0, int wr, int wc, int fr, int fq, float (&r)[2][4]) {
    extern __shared__ __attribute__((aligned(16))) unsigned char lds_dyn_base[];
    LAS float* rc = (LAS float*)((LAS unsigned char*)lds_dyn_base + RSTD_CACHE_OFF) + wr * 64 + fr;
    if (pm != last_pm) { rows_rstd(rs, row0, fq, r); last_pm = pm;
        if (wc == 0 && fq == 0) {
#pragma unroll
            for (int ai = 0; ai < 2; ++ai)
#pragma unroll
                for (int m = 0; m < 4; ++m) rc[ai * 128 + m * 16] = r[ai][m]; } }
    else {
#pragma unroll
        for (int ai = 0; ai < 2; ++ai)
#pragma unroll
            for (int m = 0; m < 4; ++m) r[ai][m] = rc[ai * 128 + m * 16]; }
}
struct EpiUV {
    static constexpr bool PERM = true, AFTER_DRAIN = false;
    bf16* U; bf16* V; float* rowss; const float* rs_in; mutable int last_pm = -1;
    __device__ __forceinline__ void operator()(const pg8::f32x4 (&acc)[2][2][4][2], const pg8::Unit& u, int wr, int wc, int fr_, int fq_) const {
        int fr = fr_, fq = fq_; asm volatile("" : "+v"(fr), "+v"(fq));
        const bool isv = u.pn >= 4; bf16* base = isv ? V : U;
        const int row0 = u.pm * 256 + wr * 64 + fr, col0 = (u.pn & 3) * 256 + wc * 32 + 8 * fq;
        float rs8[2][4]; rows_rstd_cached(rs_in, u.pm, last_pm, row0, wr, wc, fr, fq, rs8);
#pragma unroll
        for (int ai = 0; ai < 2; ++ai)
#pragma unroll
            for (int m = 0; m < 4; ++m) { const int row = row0 + ai * 128 + m * 16; float ss = 0.f; const float rstd = rs8[ai][m];
#pragma unroll
                for (int bj = 0; bj < 2; ++bj) { const pg8::f32x4 v0 = acc[ai][bj][m][0] * rstd, v1 = acc[ai][bj][m][1] * rstd;
                    ss += (v0[0] * v0[0] + v0[1] * v0[1]) + (v0[2] * v0[2] + v0[3] * v0[3]) + (v1[0] * v1[0] + v1[1] * v1[1]) + (v1[2] * v1[2] + v1[3] * v1[3]);
                    v4u w; w.x = pk2(v0[0], v0[1]); w.y = pk2(v0[2], v0[3]); w.z = pk2(v1[0], v1[1]); w.w = pk2(v1[2], v1[3]);
                    *(v4u*)(base + (size_t)row * DM + col0 + bj * 128) = w; }
                if (isv) { ss += __shfl_xor(ss, 16); ss += __shfl_xor(ss, 32); if (fq == 0) rowss[(size_t)row * 16 + (u.pn - 4) * 4 + wc] = ss; } }
    }
};
struct EpiSqRelu {
    static constexpr bool PERM = true, AFTER_DRAIN = false;
    bf16* O; int ldc; const float* rs_in; mutable int last_pm = -1;
    __device__ __forceinline__ void operator()(const pg8::f32x4 (&acc)[2][2][4][2], const pg8::Unit& u, int wr, int wc, int fr_, int fq_) const {
        int fr = fr_, fq = fq_; asm volatile("" : "+v"(fr), "+v"(fq));
        const int row0 = u.pm * 256 + wr * 64 + fr, col0 = u.pn * 256 + wc * 32 + 8 * fq;
        float rs8[2][4]; rows_rstd_cached(rs_in, u.pm, last_pm, row0, wr, wc, fr, fq, rs8);
#pragma unroll
        for (int ai = 0; ai < 2; ++ai)
#pragma unroll
            for (int m = 0; m < 4; ++m) { const int row = row0 + ai * 128 + m * 16; const float rstd = rs8[ai][m];
#pragma unroll
                for (int bj = 0; bj < 2; ++bj) { pg8::f32x4 v0 = acc[ai][bj][m][0], v1 = acc[ai][bj][m][1];
#pragma unroll
                    for (int e = 0; e < 4; ++e) { const float a = fmaxf(v0[e] * rstd, 0.f), b = fmaxf(v1[e] * rstd, 0.f); v0[e] = a * a; v1[e] = b * b; }
                    v4u w; w.x = pk2(v0[0], v0[1]); w.y = pk2(v0[2], v0[3]); w.z = pk2(v1[0], v1[1]); w.w = pk2(v1[2], v1[3]);
                    *(v4u*)(O + (size_t)row * ldc + col0 + bj * 128) = w; } }
    }
};
struct EpiStore {
    static constexpr bool PERM = true, AFTER_DRAIN = false;
    bf16* O; int ldc;
    __device__ __forceinline__ void operator()(const pg8::f32x4 (&acc)[2][2][4][2], const pg8::Unit& u, int wr, int wc, int fr_, int fq_) const {
        int fr = fr_, fq = fq_; asm volatile("" : "+v"(fr), "+v"(fq));
        const int row0 = u.pm * 256 + wr * 64 + fr, col0 = u.pn * 256 + wc * 32 + 8 * fq;
#pragma unroll
        for (int ai = 0; ai < 2; ++ai)
#pragma unroll
            for (int m = 0; m < 4; ++m) { const int row = row0 + ai * 128 + m * 16;
#pragma unroll
                for (int bj = 0; bj < 2; ++bj) { const pg8::f32x4 v0 = acc[ai][bj][m][0], v1 = acc[ai][bj][m][1];
                    v4u w; w.x = pk2(v0[0], v0[1]); w.y = pk2(v0[2], v0[3]); w.z = pk2(v1[0], v1[1]); w.w = pk2(v1[2], v1[3]);
                    *(v4u*)(O + (size_t)row * ldc + col0 + bj * 128) = w; } }
    }
};
struct TBOrder {
    int G, c;
    __device__ __forceinline__ bool next(int i, pg8::Unit& u) const {
        if (G != 256) { const int L = i * G + c; if (L >= 1088) return false; const int kv = L >= 544 ? 1 : 0, r = L - 544 * kv; u.pm = 272 * kv + (r >> 1); u.pn = 2 * kv + (r & 1); return true; }
        const int x = c & 7, y = c >> 3, pmidx = i * 128 + (y >> 1) * 8 + x; if (pmidx >= 544) return false;
        const int kv = pmidx >= 272 ? 1 : 0; u.pm = pmidx; u.pn = 2 * kv + (y & 1); return true; }
    __device__ __forceinline__ void a_ready(const pg8::Unit&) const {}
    __device__ __forceinline__ void done(const pg8::Unit&) const {}
};
__device__ __forceinline__ float gelu_tanh(float x) { const float y = 0.7978845608028654f * (x + 0.044715f * x * x * x); return x / (1.f + __expf(-2.f * y)); }
__device__ __forceinline__ void combine16_fused(const bf16* __restrict__ HBk, const bf16* __restrict__ w2t, bf16* __restrict__ outp, int un, int lane) {
    const int m = un * 16 + (lane & 15), ko = 8 * (lane >> 4); const bool dead = ((m >> 2) & 511) == 511;
    f32x4 acc[4];
#pragma unroll
    for (int nt = 0; nt < 4; ++nt) acc[nt] = (f32x4){0.f, 0.f, 0.f, 0.f};
    v4u hva[8];
#pragma unroll
    for (int ks = 0; ks < 8; ++ks) hva[ks] = *(const v4u*)(HBk + (size_t)m * 256 + 32 * ks + ko);
#pragma unroll
    for (int ks = 0; ks < 8; ++ks) { const int k = 32 * ks + ko; const bf16x8 hf = __builtin_bit_cast(bf16x8, hva[ks]);
#pragma unroll
        for (int nt = 0; nt < 4; ++nt) { const bf16x8 wf = *(const bf16x8*)(w2t + (size_t)(16 * nt + (lane & 15)) * 256 + k);
            acc[nt] = __builtin_amdgcn_mfma_f32_16x16x32_bf16(wf, hf, acc[nt], 0, 0, 0); } }
#pragma unroll
    for (int nt = 0; nt < 4; ++nt) { v2u o; o.x = dead ? 0u : pk2(acc[nt][0], acc[nt][1]); o.y = dead ? 0u : pk2(acc[nt][2], acc[nt][3]);
        *(v2u*)(outp + (size_t)m * 64 + 16 * nt + 4 * (lane >> 4)) = o; }
}
__device__ __forceinline__ void combine16_tb(const bf16* __restrict__ TB, const float* __restrict__ bias1, const bf16* __restrict__ w2t, bf16* __restrict__ outp, int un, int lane) {
    const int m = un * 16 + (lane & 15), ko = 8 * (lane >> 4); const bool dead = ((m >> 2) & 511) == 511;
    f32x4 acc[4];
#pragma unroll
    for (int nt = 0; nt < 4; ++nt) acc[nt] = (f32x4){0.f, 0.f, 0.f, 0.f};
    v4u tva[8], bva[8];
#pragma unroll
    for (int ks = 0; ks < 8; ++ks) { const int k = 32 * ks + ko; tva[ks] = (v4u){0u, 0u, 0u, 0u}; bva[ks] = (v4u){0u, 0u, 0u, 0u};
        if (!dead) { tva[ks] = *(const v4u*)(TB + (size_t)m * 512 + k); bva[ks] = *(const v4u*)(TB + (size_t)(m + 4) * 512 + 256 + k); } }
#pragma unroll
    for (int ks = 0; ks < 8; ++ks) { const int k = 32 * ks + ko; const v4u tv = tva[ks], bv = bva[ks];
        const f32x4 b0 = *(const f32x4*)(bias1 + k), b1 = *(const f32x4*)(bias1 + k + 4);
        v4u hp;
        hp.x = pk2(gelu_tanh(bf_lo(tv.x) + bf_lo(bv.x) + b0.x), gelu_tanh(bf_hi(tv.x) + bf_hi(bv.x) + b0.y));
        hp.y = pk2(gelu_tanh(bf_lo(tv.y) + bf_lo(bv.y) + b0.z), gelu_tanh(bf_hi(tv.y) + bf_hi(bv.y) + b0.w));
        hp.z = pk2(gelu_tanh(bf_lo(tv.z) + bf_lo(bv.z) + b1.x), gelu_tanh(bf_hi(tv.z) + bf_hi(bv.z) + b1.y));
        hp.w = pk2(gelu_tanh(bf_lo(tv.w) + bf_lo(bv.w) + b1.z), gelu_tanh(bf_hi(tv.w) + bf_hi(bv.w) + b1.w));
        const bf16x8 hf = __builtin_bit_cast(bf16x8, hp);
#pragma unroll
        for (int nt = 0; nt < 4; ++nt) { const bf16x8 wf = *(const bf16x8*)(w2t + (size_t)(16 * nt + (lane & 15)) * 256 + k);
            acc[nt] = __builtin_amdgcn_mfma_f32_16x16x32_bf16(wf, hf, acc[nt], 0, 0, 0); } }
#pragma unroll
    for (int nt = 0; nt < 4; ++nt) { v2u o; o.x = dead ? 0u : pk2(acc[nt][0], acc[nt][1]); o.y = dead ? 0u : pk2(acc[nt][2], acc[nt][3]);
        *(v2u*)(outp + (size_t)m * 64 + 16 * nt + 4 * (lane >> 4)) = o; }
}
struct TBFOrder {
    int G, c; const bf16* HB; const bf16* W2; bf16* KC; bf16* VC;
    __device__ __forceinline__ bool next(int i, pg8::Unit& u) const { const int L = i * G + c; if (L >= 512) return false; const int kv = L >> 8, idx = L & 255, rt = idx < 240 ? idx : idx + 16; u.pm = 272 * kv + rt; u.pn = kv; return true; }
    __device__ __forceinline__ void a_ready(const pg8::Unit&) const {}
    __device__ __forceinline__ void done(const pg8::Unit& u) const {
        asm volatile("s_waitcnt vmcnt(0)" ::: "memory");
        __syncthreads();
        int tid_l = threadIdx.x; asm volatile("" : "+v"(tid_l)); const int lane = tid_l & 63, w = __builtin_amdgcn_readfirstlane(tid_l >> 6);
        const int kv = u.pn, un0 = (u.pm - 272 * kv) * 16 + 2 * w;
        const bf16* HBk = HB + (size_t)kv * ACMP_ROWS * 256; const bf16* w2t = W2 + (size_t)kv * 64 * 256; bf16* outp = kv ? VC : KC;
        combine16_fused(HBk, w2t, outp, un0, lane); combine16_fused(HBk, w2t, outp, un0 + 1, lane);
    }
};
struct TBEarlyOrder {
    int G, c;
    __device__ __forceinline__ bool next(int i, pg8::Unit& u) const { int e;
        if (G == 256) { if (i != 0 || c < 192) return false; e = c - 192; } else { e = i * G + c; if (e >= 64) return false; }
        const int x = e & 7, y = e >> 3, pidx = (y >> 1) * 8 + x, kv = pidx >> 4; u.pm = 272 * kv + 240 + (pidx & 15); u.pn = 2 * kv + (y & 1); return true; }
    __device__ __forceinline__ void a_ready(const pg8::Unit&) const {}
    __device__ __forceinline__ void done(const pg8::Unit&) const {}
};
struct EpiH {
    static constexpr bool PERM = true, AFTER_DRAIN = false;
    bf16* HB; const float* bias1;
    __device__ __forceinline__ void operator()(const pg8::f32x4 (&acc)[2][2][4][2], const pg8::Unit& u, int wr, int wc, int fr_, int fq_) const {
        int fr = fr_, fq = fq_; asm volatile("" : "+v"(fr), "+v"(fq));
        const int row0 = u.pm * 256 + wr * 64 + fr, col0 = wc * 32 + 8 * fq; const float* bp = bias1 + u.pn * 256 + col0;
#pragma unroll
        for (int bj = 0; bj < 2; ++bj) { const pg8::f32x4 b0 = *(const pg8::f32x4*)(bp + bj * 128), b1 = *(const pg8::f32x4*)(bp + bj * 128 + 4);
#pragma unroll
            for (int ai = 0; ai < 2; ++ai)
#pragma unroll
                for (int m = 0; m < 4; ++m) { const int row = row0 + ai * 128 + m * 16; const pg8::f32x4 v0 = acc[ai][bj][m][0] + b0, v1 = acc[ai][bj][m][1] + b1;
                    v4u w; w.x = pk2(gelu_tanh(v0[0]), gelu_tanh(v0[1])); w.y = pk2(gelu_tanh(v0[2]), gelu_tanh(v0[3])); w.z = pk2(gelu_tanh(v1[0]), gelu_tanh(v1[1])); w.w = pk2(gelu_tanh(v1[2]), gelu_tanh(v1[3]));
                    *(v4u*)(HB + (size_t)row * 256 + col0 + bj * 128) = w; } }
    }
};
struct EpiTB {
    static constexpr bool PERM = true, AFTER_DRAIN = false;
    bf16* TB;
    __device__ __forceinline__ void operator()(const pg8::f32x4 (&acc)[2][2][4][2], const pg8::Unit& u, int wr, int wc, int fr_, int fq_) const {
        int fr = fr_, fq = fq_; asm volatile("" : "+v"(fr), "+v"(fq));
        const int kv = u.pn >> 1; bf16* O = TB + (size_t)kv * (WS_TB_STRIDE / 2);
        const int row0 = (u.pm - 272 * kv) * 256 + wr * 64 + fr, col0 = (u.pn & 1) * 256 + wc * 32 + 8 * fq;
#pragma unroll
        for (int ai = 0; ai < 2; ++ai)
#pragma unroll
            for (int m = 0; m < 4; ++m) { const int row = row0 + ai * 128 + m * 16;
#pragma unroll
                for (int bj = 0; bj < 2; ++bj) { const pg8::f32x4 v0 = acc[ai][bj][m][0], v1 = acc[ai][bj][m][1];
                    v4u w; w.x = pk2(v0[0], v0[1]); w.y = pk2(v0[2], v0[3]); w.z = pk2(v1[0], v1[1]); w.w = pk2(v1[2], v1[3]);
                    *(v4u*)(O + (size_t)row * 512 + col0 + bj * 128) = w; } }
    }
};
struct EpiResid {
    static constexpr bool PERM = true, AFTER_DRAIN = false;
    bf16* xb; float* rs_out;
    __device__ __forceinline__ void operator()(const pg8::f32x4 (&acc)[2][2][4][2], const pg8::Unit& u, int wr, int wc, int fr_, int fq_) const {
        int fr = fr_, fq = fq_; asm volatile("" : "+v"(fr), "+v"(fq));
        const int row0 = u.pm * 256 + wr * 64 + fr, col0 = u.pn * 256 + wc * 32 + 8 * fq;
#pragma unroll
        for (int ai = 0; ai < 2; ++ai) {
            v4u bx[4][2];
#pragma unroll
            for (int m = 0; m < 4; ++m)
#pragma unroll
                for (int bj = 0; bj < 2; ++bj) bx[m][bj] = *(const v4u*)(xb + (size_t)(row0 + ai * 128 + m * 16) * DM + col0 + bj * 128);
            asm volatile("" ::: "memory");
#pragma unroll
            for (int m = 0; m < 4; ++m) { const int row = row0 + ai * 128 + m * 16; float ss = 0.f;
#pragma unroll
                for (int bj = 0; bj < 2; ++bj) { const v4u b = bx[m][bj]; const pg8::f32x4 a0 = acc[ai][bj][m][0], a1 = acc[ai][bj][m][1];
                    const float x0 = bf_lo(b.x) + a0[0], x1 = bf_hi(b.x) + a0[1], x2 = bf_lo(b.y) + a0[2], x3 = bf_hi(b.y) + a0[3];
                    const float x4 = bf_lo(b.z) + a1[0], x5 = bf_hi(b.z) + a1[1], x6 = bf_lo(b.w) + a1[2], x7 = bf_hi(b.w) + a1[3];
                    ss += ((x0 * x0 + x1 * x1) + (x2 * x2 + x3 * x3)) + ((x4 * x4 + x5 * x5) + (x6 * x6 + x7 * x7));
                    v4u w; w.x = pk2(x0, x1); w.y = pk2(x2, x3); w.z = pk2(x4, x5); w.w = pk2(x6, x7);
                    *(v4u*)(xb + (size_t)row * DM + col0 + bj * 128) = w; }
                ss += __shfl_xor(ss, 16); ss += __shfl_xor(ss, 32); if (fq == 0) rs_out[(size_t)row * 16 + u.pn * 4 + wc] = ss; }
            asm volatile("" ::: "memory");
        }
    }
};
struct EpiKVQG {
    static constexpr bool PERM = false, AFTER_DRAIN = false;
    float* out; bf16* acmp; bf16* ksel; bf16* kwin; bf16* q; float* gates; const float* bg; int tile_off; const float* rs_in; mutable int last_pm = -1;
    __device__ __forceinline__ void operator()(const pg8::f32x4 (&acc)[2][2][4][2], const pg8::Unit& u, int wr, int wc, int fr_, int fq_) const {
        int fr = fr_, fq = fq_; asm volatile("" : "+v"(fr), "+v"(fq));
        const int kind = u.pn + tile_off;
        const int row0 = u.pm * 256 + wr * 64 + fr, cw = wc * 32 + 4 * fq;
        float rs8[2][4]; rows_rstd_cached(rs_in, u.pm, last_pm, row0, wr, wc, fr, fq, rs8);
#pragma unroll
        for (int ai = 0; ai < 2; ++ai)
#pragma unroll
            for (int m = 0; m < 4; ++m) { const int row = row0 + ai * 128 + m * 16, b = row >> 13, t = row & 8191; const float rstd = rs8[ai][m];
#pragma unroll
                for (int bj = 0; bj < 2; ++bj)
#pragma unroll
                    for (int n = 0; n < 2; ++n) { const int ct = cw + bj * 128 + n * 16; const pg8::f32x4 v = acc[ai][bj][m][n] * rstd;
                        if (kind < 2) {
                            *(pg8::f32x4*)(out + O_CMP + (size_t)row * 512 + kind * 256 + ct) = v;
                            bf16* dst = acmp + ((size_t)kind * ACMP_ROWS + 65536 + (size_t)((b * 512 + (t >> 4)) * 4 + (ct >> 6))) * 1024 + (t & 15) * 64 + (ct & 63);
                            v2u w; w.x = pk2(v[0], v[1]); w.y = pk2(v[2], v[3]); *(v2u*)dst = w;
                        } else if (kind < 4) {
                            *(pg8::f32x4*)(out + O_SEL + (size_t)row * 512 + (kind - 2) * 256 + ct) = v;
                            v2u w; w.x = pk2(v[0], v[1]); w.y = pk2(v[2], v[3]); *(v2u*)(ksel + (size_t)row * 512 + (kind - 2) * 256 + ct) = w;
                        } else if (kind < 6) {
                            if (t >= SEQ - 512) *(pg8::f32x4*)(out + O_WIN + (size_t)(b * 512 + t - (SEQ - 512)) * 512 + (kind - 4) * 256 + ct) = v;
                            v2u w; w.x = pk2(v[0], v[1]); w.y = pk2(v[2], v[3]); *(v2u*)(kwin + (size_t)row * 512 + (kind - 4) * 256 + ct) = w;
                        } else if (kind < 10) {
                            v2u w; w.x = pk2(v[0] * C2, v[1] * C2); w.y = pk2(v[2] * C2, v[3] * C2); *(v2u*)(q + (size_t)row * DM + (kind - 6) * 256 + ct) = w;
                        } else {
                            if (ct < 48) { pg8::f32x4 o;
#pragma unroll
                                for (int e = 0; e < 4; ++e) o[e] = 1.f / (1.f + __expf(-(v[e] + bg[ct + e])));
                                *(pg8::f32x4*)(gates + (size_t)row * 48 + ct) = o; }
                        } } }
    }
};

template <int NT, class Epi>
__device__ __forceinline__ void wave_gemm16(const bf16* __restrict__ A, const bf16* __restrict__ W, int M, int N, int gw, int NGW, int lane, const Epi& E) {
    const int ncg = N / (16 * NT), nun = (M >> 4) * ncg;
    for (int un = gw; un < nun; un += NGW) { const int rt = un / ncg, cg = un - rt * ncg;
        f32x4 acc[NT];
#pragma unroll
        for (int nt = 0; nt < NT; ++nt) acc[nt] = (f32x4){0.f, 0.f, 0.f, 0.f};
        const bf16* ap = A + (size_t)(rt * 16 + (lane & 15)) * 1024 + 8 * (lane >> 4);
        const bf16* wp = W + (size_t)(cg * NT * 16 + (lane & 15)) * 1024 + 8 * (lane >> 4);
#pragma unroll 4
        for (int k = 0; k < 1024; k += 32) { const bf16x8 a = *(const bf16x8*)(ap + k);
#pragma unroll
            for (int nt = 0; nt < NT; ++nt) { const bf16x8 w = *(const bf16x8*)(wp + (size_t)nt * 16 * 1024 + k); acc[nt] = __builtin_amdgcn_mfma_f32_16x16x32_bf16(w, a, acc[nt], 0, 0, 0); } }
#pragma unroll
        for (int nt = 0; nt < NT; ++nt) E(rt * 16 + (lane & 15), (cg * NT + nt) * 16 + 4 * (lane >> 4), acc[nt]);
    }
}
struct WgStoreBf16 { bf16* O; int ldc; __device__ __forceinline__ void operator()(int row, int col0, const f32x4& v) const { v2u w; w.x = pk2(v[0], v[1]); w.y = pk2(v[2], v[3]); *(v2u*)(O + (size_t)row * ldc + col0) = w; } };
struct WgGates { float* gates; const float* bg; const float* rs;
    __device__ __forceinline__ void operator()(int row, int col0, const f32x4& v) const {
        const f32x4* p = (const f32x4*)(rs + (size_t)row * 16); const f32x4 a = p[0], b = p[1], c = p[2], d = p[3];
        const float t = ((a[0] + a[1]) + (a[2] + a[3])) + ((b[0] + b[1]) + (b[2] + b[3])) + ((c[0] + c[1]) + (c[2] + c[3])) + ((d[0] + d[1]) + (d[2] + d[3]));
        const float rstd = rsqrtf(t * (1.f / DM) + EPS); f32x4 o;
#pragma unroll
        for (int e = 0; e < 4; ++e) o[e] = 1.f / (1.f + __expf(-(v[e] * rstd + bg[col0 + e])));
        *(f32x4*)(gates + (size_t)row * 48 + col0) = o; } };

template <class Epi>
__device__ __forceinline__ void skinny_gemm(LAS unsigned char* lds, const bf16* __restrict__ A, const bf16* __restrict__ Wt, int K, int N, const Epi& E) {
    int tid_l = threadIdx.x; asm volatile("" : "+v"(tid_l)); const int tid = tid_l, lane = tid & 63, wid = tid >> 6;
    LAS float* red = (LAS float*)lds;
    const int kper = K >> 3, kbeg = wid * kper;
    for (int u = blockIdx.x; u < (N >> 4); u += gridDim.x) {
        f32x4 acc0 = {0.f, 0.f, 0.f, 0.f}, acc1 = {0.f, 0.f, 0.f, 0.f};
        const bf16* wrow = Wt + (size_t)(u * 16 + (lane & 15)) * K + kbeg + 8 * (lane >> 4);
        const bf16* a0 = A + (size_t)(lane & 15) * K + kbeg + 8 * (lane >> 4);
        const bf16* a1 = a0 + (size_t)16 * K;
#pragma unroll 4
        for (int k = 0; k < kper; k += 32) {
            const bf16x8 b = *(const bf16x8*)(wrow + k), x0 = *(const bf16x8*)(a0 + k), x1 = *(const bf16x8*)(a1 + k);
            acc0 = __builtin_amdgcn_mfma_f32_16x16x32_bf16(x0, b, acc0, 0, 0, 0);
            acc1 = __builtin_amdgcn_mfma_f32_16x16x32_bf16(x1, b, acc1, 0, 0, 0);
        }
        *(LAS f32x4*)(red + ((wid * 2 + 0) * 64 + lane) * 4) = acc0;
        *(LAS f32x4*)(red + ((wid * 2 + 1) * 64 + lane) * 4) = acc1;
        __syncthreads();
        { const int row = tid >> 4, col = tid & 15, mb = row >> 4, rr = row & 15, ln = col + 16 * (rr >> 2), rg = rr & 3; float s = 0.f;
#pragma unroll
          for (int w = 0; w < 8; ++w) s += red[((w * 2 + mb) * 64 + ln) * 4 + rg];
          E(row, u * 16 + col, s); }
        __syncthreads();
    }
}

constexpr int SKA_STRIDE = 2064, SKA_RSTD = 32 * SKA_STRIDE, SKA_RED = SKA_RSTD + 512;
template <class Epi>
__device__ __forceinline__ void skinny_gemm_hs(LAS unsigned char* lds, const float* __restrict__ HS, const bf16* __restrict__ Wt, int N, const Epi& E) {
    int tid_l = threadIdx.x; asm volatile("" : "+v"(tid_l)); const int tid = tid_l, lane = tid & 63, wid = tid >> 6;
    if ((int)blockIdx.x >= (N >> 4)) return;
    LAS float* rstd_l = (LAS float*)(lds + SKA_RSTD); LAS float* red = (LAS float*)(lds + SKA_RED);
    { const int row = tid >> 4, c16 = tid & 15; const float* src = HS + row * DM + c16 * 64; float ss = 0.f;
#pragma unroll
      for (int i = 0; i < 16; i += 2) { const f32x4 a = *(const f32x4*)(src + 4 * i), b = *(const f32x4*)(src + 4 * i + 4);
          ss += (a.x * a.x + a.y * a.y) + (a.z * a.z + a.w * a.w) + (b.x * b.x + b.y * b.y) + (b.z * b.z + b.w * b.w);
          v4u w; w.x = pk2(a.x, a.y); w.y = pk2(a.z, a.w); w.z = pk2(b.x, b.y); w.w = pk2(b.z, b.w);
          *(LAS v4u*)(lds + row * SKA_STRIDE + (c16 * 64 + 4 * i) * 2) = w; }
      ss += __shfl_xor(ss, 1); ss += __shfl_xor(ss, 2); ss += __shfl_xor(ss, 4); ss += __shfl_xor(ss, 8);
      if (c16 == 0) rstd_l[row] = rsqrtf(ss * (1.f / DM) + EPS); }
    __syncthreads();
    const int kbeg = wid * 128;
    for (int u = blockIdx.x; u < (N >> 4); u += gridDim.x) {
        f32x4 acc0 = {0.f, 0.f, 0.f, 0.f}, acc1 = {0.f, 0.f, 0.f, 0.f};
        const bf16* wrow = Wt + (size_t)(u * 16 + (lane & 15)) * DM + kbeg + 8 * (lane >> 4);
        const LAS unsigned char* a0 = lds + (lane & 15) * SKA_STRIDE + (kbeg + 8 * (lane >> 4)) * 2;
#pragma unroll
        for (int k = 0; k < 128; k += 32) {
            const bf16x8 b = *(const bf16x8*)(wrow + k), x0 = *(const LAS bf16x8*)(a0 + 2 * k), x1 = *(const LAS bf16x8*)(a0 + 16 * SKA_STRIDE + 2 * k);
            acc0 = __builtin_amdgcn_mfma_f32_16x16x32_bf16(x0, b, acc0, 0, 0, 0);
            acc1 = __builtin_amdgcn_mfma_f32_16x16x32_bf16(x1, b, acc1, 0, 0, 0);
        }
        *(LAS f32x4*)(red + ((wid * 2 + 0) * 64 + lane) * 4) = acc0;
        *(LAS f32x4*)(red + ((wid * 2 + 1) * 64 + lane) * 4) = acc1;
        __syncthreads();
        { const int row = tid >> 4, col = tid & 15, mb = row >> 4, rr = row & 15, ln = col + 16 * (rr >> 2), rg = rr & 3; float s = 0.f;
#pragma unroll
          for (int w = 0; w < 8; ++w) s += red[((w * 2 + mb) * 64 + ln) * 4 + rg];
          E(row, u * 16 + col, s * rstd_l[row]); }
        __syncthreads();
    }
}
struct SkUV { float* usu; float* vsf; __device__ __forceinline__ void operator()(int r, int c, float s) const { if (c < DM) usu[r * DM + c] = s; else vsf[r * DM + c - DM] = s; } };
struct SkResid { float* hs; __device__ __forceinline__ void operator()(int r, int c, float s) const { hs[r * DM + c] += s; } };
struct SkSqRelu { bf16* h; __device__ __forceinline__ void operator()(int r, int c, float s) const { const float a = fmaxf(s, 0.f); h[r * FF + c] = (bf16)(pk2(a * a, 0.f) & 0xffffu); } };
struct SkKVQG { float* out; float* qs; float* gs; const float* bg; int col_off;
    __device__ __forceinline__ void operator()(int r, int c0, float s) const { const int c = c0 + col_off;
        if (c < 512) out[O_CMPS + r * 512 + c] = s;
        else if (c < 1024) out[O_SELS + r * 512 + c - 512] = s;
        else if (c < 1536) out[O_WINS + (size_t)(r * 512 + 511) * 512 + c - 1024] = s;
        else if (c < 2560) qs[r * DM + c - 1536] = s * C2;
        else if (c < 2608) gs[r * 48 + c - 2560] = 1.f / (1.f + __expf(-(s + bg[c - 2560]))); } };

__device__ const unsigned char NSA_QB[128] = {112, 72, 46, 6, 104, 98, 31, 3, 95, 75, 50, 16, 123, 88, 21, 4, 110, 74, 39, 13, 103, 67, 61, 5, 83, 79, 56, 18, 118, 49, 42, 27, 106, 45, 44, 41, 100, 70, 55, 11, 102, 58, 40, 36, 85, 62, 51, 38, 125, 47, 35, 29, 127, 65, 25, 19, 119, 76, 32, 9, 109, 53, 48, 26, 122, 89, 59, 2, 105, 91, 52, 24, 111, 90, 37, 34, 96, 87, 81, 8, 117, 69, 64, 22, 126, 66, 57, 23, 114, 80, 71, 7, 97, 84, 77, 14, 107, 93, 60, 12, 101, 92, 78, 1, 115, 94, 33, 30, 113, 86, 73, 0, 116, 82, 54, 20, 124, 68, 63, 17, 121, 108, 28, 15, 120, 99, 43, 10};
struct Frame {
    LAS unsigned char* lds; volatile LAS unsigned* MISC;
    int tid, lane, wave, G, gw, NGW;
    unsigned char* ws; float* out;
};
constexpr int PTAB_OFF = LDSCTL_OFF + 1024;
__device__ __forceinline__ const void* tab_ptr(LAS unsigned char* lds, int i) {
    const unsigned long long v = *(volatile LAS unsigned long long*)(lds + PTAB_OFF + 8 * i);
    const unsigned lo = __builtin_amdgcn_readfirstlane((unsigned)v), hi = __builtin_amdgcn_readfirstlane((unsigned)(v >> 32));
    const GAS char* gp = (const GAS char*)(((unsigned long long)hi << 32) | lo);
    return (const void*)gp;
}
#define INF(i) ((const float*)tab_ptr(F.lds, (i)))

struct TTask { const float* W; int ld, col0, ncols; const float* gain; bf16* dst; int K, npad, ilv; };
__device__ __forceinline__ void transpose_item(const TTask& T, LAS float* scr, int item, int lane) {
    const int nblk = T.npad >> 5, kb = item / nblk, nb = item - kb * nblk, k0 = 64 * kb, n0 = 32 * nb;
    const int n = n0 + (lane & 31); const bool ok = n < T.ncols;
    const int k0d = T.ilv ? ((kb & 15) * 128 + (kb >> 4) * 64) : k0;
    float wv[32];
#pragma unroll
    for (int i = 0; i < 32; ++i) { const int kk = 2 * i + (lane >> 5); wv[i] = ok ? T.W[(size_t)(k0 + kk) * T.ld + T.col0 + n] : 0.f; }
#pragma unroll
    for (int i = 0; i < 32; ++i) { const int kk = 2 * i + (lane >> 5); float w = wv[i]; if (T.gain) w *= T.gain[k0 + kk]; scr[kk * 33 + (lane & 31)] = w; }
    LDS_WAIT(); asm volatile("" ::: "memory");
    const int c = lane & 7;
#pragma unroll
    for (int j = 0; j < 4; ++j) { const int nn = (lane >> 3) + 8 * j; const LAS float* s = scr + (8 * c) * 33 + nn;
        v4u o; o.x = pk2(s[0 * 33], s[1 * 33]); o.y = pk2(s[2 * 33], s[3 * 33]); o.z = pk2(s[4 * 33], s[5 * 33]); o.w = pk2(s[6 * 33], s[7 * 33]);
        *(v4u*)(T.dst + (size_t)(n0 + nn) * T.K + k0d + 8 * c) = o; }
    LDS_WAIT(); asm volatile("" ::: "memory");
}
constexpr int N_TTASK = 29;
__device__ __forceinline__ int get_ttask(Frame& F, int t, TTask& T) {
    unsigned char* ws = F.ws;
    if (t < 2)       { const int i = t;      T = TTask{INF(7) + (size_t)i * 1024 * 2048, 2048, 0, 2048, INF(6) + i * 1024, (bf16*)(ws + WS_WUV) + (size_t)i * 2048 * 1024, 1024, 2048}; }
    else if (t < 4)  { const int i = t - 2;  T = TTask{INF(11) + (size_t)i * 1024 * 1024, 1024, 0, 1024, nullptr, (bf16*)(ws + WS_WAO) + (size_t)i * 1024 * 1024, 1024, 1024}; }
    else if (t == 4) {                       T = TTask{INF(13), 1536, 0, 1536, INF(12), (bf16*)(ws + WS_WKVQG), 1024, 1536}; }
    else if (t == 5) {                       T = TTask{INF(21), 1072, 0, 1024, INF(20), (bf16*)(ws + WS_WKVQG) + (size_t)1536 * 1024, 1024, 1024}; }
    else if (t == 6) {                       T = TTask{INF(21), 1072, 1024, 48, INF(20), (bf16*)(ws + WS_WKVQG) + (size_t)2560 * 1024, 1024, 256}; }
    else if (t == 7) {                       T = TTask{INF(21) + (size_t)1024 * 1072, 1072, 0, 1024, INF(20) + 1024, (bf16*)(ws + WS_WQG1), 1024, 1024}; }
    else if (t == 8) {                       T = TTask{INF(21) + (size_t)1024 * 1072, 1072, 1024, 48, INF(20) + 1024, (bf16*)(ws + WS_WQG1) + (size_t)1024 * 1024, 1024, 256}; }
    else if (t < 11) { const int i = t - 9;  T = TTask{INF(23) + (size_t)i * 1024 * 1024, 1024, 0, 1024, nullptr, (bf16*)(ws + WS_WBO) + (size_t)i * 1024 * 1024, 1024, 1024}; }
    else if (t < 15) { const int i = t - 11; T = TTask{INF(25) + (size_t)i * 1024 * 4096, 4096, 0, 4096, INF(24) + i * 1024, (bf16*)(ws + WS_WUP) + (size_t)i * 4096 * 1024, 1024, 4096}; }
    else if (t < 19) { const int i = t - 15; T = TTask{INF(26) + (size_t)i * 4096 * 1024, 1024, 0, 1024, nullptr, (bf16*)(ws + WS_WDN) + (size_t)i * 1024 * 4096, 4096, 1024}; }
    else if (t < 23) { const int i = t - 19, kv = i >> 1, half = i & 1;
                       T = TTask{INF(kv ? 18 : 15) + (size_t)half * 1024 * 256, 256, 0, 256, nullptr, (bf16*)(ws + WS_WC1) + (size_t)kv * 512 * 1024 + (size_t)half * 256 * 1024, 1024, 256}; }
    else if (t < 25) { const int kv = t - 23; T = TTask{INF(kv ? 19 : 16), 64, 0, 64, nullptr, (bf16*)(ws + WS_WC2) + (size_t)kv * 64 * 256, 256, 64}; }
    else if (t < 27) { const int kv = t - 25; T = TTask{INF(kv ? 18 : 15), 256, 0, 256, nullptr, (bf16*)(ws + WS_WC1F) + (size_t)kv * 256 * 2048, 2048, 256, 1}; }
    else             { T = TTask{nullptr, 0, 0, 0, nullptr, nullptr, 64, 32}; return 0; }
    return (T.K >> 6) * (T.npad >> 5);
}
__device__ __forceinline__ void cvt_row_bf16_ssq(const float* xrow, bf16* orow, float* rs16, int lane) {
    const f32x4* xr = (const f32x4*)xrow + lane; f32x4 v[4]; float s = 0.f;
#pragma unroll
    for (int j = 0; j < 4; ++j) { v[j] = xr[64 * j]; s += (v[j].x * v[j].x + v[j].y * v[j].y) + (v[j].z * v[j].z + v[j].w * v[j].w); }
    s = wave_sum(s);
    unsigned long long* o8 = (unsigned long long*)orow + lane;
#pragma unroll
    for (int j = 0; j < 4; ++j) o8[64 * j] = (unsigned long long)pk2(v[j].x, v[j].y) | ((unsigned long long)pk2(v[j].z, v[j].w) << 32);
    if (lane < 16) rs16[lane] = lane == 0 ? s : 0.f;
}
__device__ __forceinline__ void norm_row_f32(const float* xrow, const float* g, float* orow, int lane) {
    const f32x4* xr = (const f32x4*)xrow + lane; const f32x4* gr = (const f32x4*)g + lane; f32x4 v[4]; float s = 0.f;
#pragma unroll
    for (int j = 0; j < 4; ++j) { v[j] = xr[64 * j]; s += (v[j].x * v[j].x + v[j].y * v[j].y) + (v[j].z * v[j].z + v[j].w * v[j].w); }
    const float rstd = rsqrtf(wave_sum(s) * (1.f / DM) + EPS);
#pragma unroll
    for (int j = 0; j < 4; ++j) { const f32x4 gg = gr[64 * j]; ((f32x4*)orow + lane)[64 * j] = v[j] * rstd * gg; }
}
__device__ __forceinline__ void norm_row_bf16(const bf16* xrow, const float* rs16, const float* g, float* orow, int lane) {
    const v4u a = *(const v4u*)(xrow + 8 * lane), b = *(const v4u*)(xrow + 512 + 8 * lane);
    float t = lane < 16 ? rs16[lane] : 0.f; t = wave_sum(t);
    const float rstd = rsqrtf(t * (1.f / DM) + EPS);
    const f32x4* gr = (const f32x4*)g; f32x4* o4 = (f32x4*)orow;
    const f32x4 g0 = gr[2 * lane], g1 = gr[2 * lane + 1], g2 = gr[128 + 2 * lane], g3 = gr[128 + 2 * lane + 1];
    o4[2 * lane]           = (f32x4){bf_lo(a.x), bf_hi(a.x), bf_lo(a.y), bf_hi(a.y)} * rstd * g0;
    o4[2 * lane + 1]       = (f32x4){bf_lo(a.z), bf_hi(a.z), bf_lo(a.w), bf_hi(a.w)} * rstd * g1;
    o4[128 + 2 * lane]     = (f32x4){bf_lo(b.x), bf_hi(b.x), bf_lo(b.y), bf_hi(b.y)} * rstd * g2;
    o4[128 + 2 * lane + 1] = (f32x4){bf_lo(b.z), bf_hi(b.z), bf_lo(b.w), bf_hi(b.w)} * rstd * g3;
}
__device__ __forceinline__ void prologue_phase(Frame& F) {
    LAS float* scr = (LAS float*)(F.lds + F.wave * 16384);
    for (int it = F.gw; ; it += F.NGW) {
        int r = it, t = 0; TTask T; int n = 0;
        for (; t < N_TTASK; ++t) { n = get_ttask(F, t, T); if (n == 0 || r < n) break; r -= n; }
        if (n == 0 || t >= N_TTASK) break;
        transpose_item(T, scr, r, F.lane);
    }
    { const float* Ws = INF(9); bf16* Wsb = (bf16*)(F.ws + WS_WSB);
      for (int i = F.gw * 64 + F.lane; i < 2 * 8 * 128 * 128; i += F.NGW * 64) { const int s = i & 127, t = (i >> 7) & 127; const float w = (s <= t) ? Ws[i] : 0.f; Wsb[i] = (bf16)(pk2(w, 0.f) & 0xffffu); } }
    { float* bias1 = (float*)(F.ws + WS_BIAS1);
      for (int o = F.gw; o < 512; o += F.NGW) { const int kv = o >> 8, n = o & 255; const float* pe = INF(kv ? 17 : 14); const float* w1 = INF(kv ? 18 : 15); float s = 0.f;
          for (int kk = F.lane; kk < 2048; kk += 64) s += pe[kk] * w1[(size_t)kk * 256 + n];
          s = wave_sum(s); if (F.lane == 0) bias1[o] = s; } }
    { const float* xp = INF(0); const float* xs = INF(1); bf16* XN = (bf16*)(F.ws + WS_XN); float* RS2 = (float*)(F.ws + WS_ROWSS2); float* HS = (float*)(F.ws + WS_HS);
      for (int m = F.gw; m < MP + NS; m += F.NGW) {
          if (m < MP) cvt_row_bf16_ssq(xp + (size_t)m * DM, XN + (size_t)m * DM, RS2 + (size_t)m * 16, F.lane);
          else { const int r = m - MP;
#pragma unroll
                 for (int j = 0; j < 4; ++j) ((f32x4*)(HS + (size_t)r * DM) + F.lane)[64 * j] = ((const f32x4*)(xs + (size_t)r * DM) + F.lane)[64 * j]; } } }
    { const float* cache = INF(2); const int* pt = (const int*)tab_ptr(F.lds, 5); bf16* acmp = (bf16*)(F.ws + WS_ACMP);
      for (int it = F.gw; it < NS * 512; it += F.NGW) { const int seq = it >> 9, jblk = it & 511; const int page = pt[seq * 64 + (jblk >> 3)];
          const float* src = cache + ((size_t)page * 128 + (jblk & 7) * 16) * 512;
#pragma unroll
          for (int i0 = 0; i0 < 32; i0 += 16) { f32x4 v[16];
#pragma unroll
              for (int j = 0; j < 16; ++j) v[j] = __builtin_nontemporal_load((const f32x4*)(src + (i0 + j) * 256 + F.lane * 4));
#pragma unroll
              for (int j = 0; j < 16; ++j) { const int i = i0 + j, r = i >> 1, kv = i & 1, g = F.lane >> 4, d = (F.lane & 15) * 4;
                  v2u w; w.x = pk2(v[j].x, v[j].y); w.y = pk2(v[j].z, v[j].w);
                  *(v2u*)(acmp + ((size_t)kv * ACMP_ROWS + (size_t)(it * 4 + g)) * 1024 + r * 64 + d) = w; } } } }
    { const float* st = INF(4); float* o = F.out + O_WINS;
      for (int it = F.gw * 4; it < NS * 511; it += F.NGW * 4) { f32x4 v[8];
#pragma unroll
          for (int j = 0; j < 4; ++j) { const int x = it + j < NS * 511 ? it + j : NS * 511 - 1, seq = x / 511, r = x - seq * 511;
              const f32x4* s4 = (const f32x4*)(st + (size_t)(seq * 512 + r + 1) * 512) + F.lane; v[2 * j] = s4[0]; v[2 * j + 1] = s4[64]; }
#pragma unroll
          for (int j = 0; j < 4; ++j) { const int x = it + j < NS * 511 ? it + j : NS * 511 - 1, seq = x / 511, r = x - seq * 511;
              f32x4* d4 = (f32x4*)(o + (size_t)(seq * 512 + r) * 512) + F.lane; d4[0] = v[2 * j]; d4[64] = v[2 * j + 1]; } } }
}

constexpr int GT_STRIDE = 272;
__device__ __forceinline__ void gating_phase(Frame& F, int layer, bf16* Uout) {
    bf16* U = (bf16*)(F.ws + WS_U); const bf16* V = (const bf16*)(F.ws + WS_V); const float* rowss = (const float*)(F.ws + WS_ROWSS);
    const bf16* Wsb = (const bf16*)(F.ws + WS_WSB) + (size_t)layer * 8 * 128 * 128;
    const float* gv = INF(8) + layer * DM; const float* bs = INF(10) + layer * 8 * 128;
    LAS unsigned char* vt = F.lds; LAS float* rstd_l = (LAS float*)(F.lds + 128 * GT_STRIDE);
    const int tid = F.tid, lane = F.lane, w = F.wave;
    for (int un = blockIdx.x; un < 1024; un += F.G) {
        const int chunk = un >> 3, g = un & 7, row0 = chunk * 128;
        if (tid < 128) { const float* p = rowss + (size_t)(row0 + tid) * 16; float s = 0.f;
#pragma unroll
            for (int i = 0; i < 16; ++i) s += p[i];
            rstd_l[tid] = rsqrtf(s * (1.f / DM) + EPS); }
        __syncthreads();
#pragma unroll
        for (int it = 0; it < 4; ++it) { const int idx = it * 512 + tid, r = idx >> 4, ch = idx & 15;
            v4u x = *(const v4u*)(V + (size_t)(row0 + r) * DM + g * 128 + ch * 8); const float rs = rstd_l[r];
            v4u y; y.x = pk2(bf_lo(x.x) * rs, bf_hi(x.x) * rs); y.y = pk2(bf_lo(x.y) * rs, bf_hi(x.y) * rs); y.z = pk2(bf_lo(x.z) * rs, bf_hi(x.z) * rs); y.w = pk2(bf_lo(x.w) * rs, bf_hi(x.w) * rs);
            *(LAS v4u*)(vt + r * GT_STRIDE + ch * 16) = y; }
        __syncthreads();
        f32x4 acc[8];
#pragma unroll
        for (int nt = 0; nt < 8; ++nt) acc[nt] = (f32x4){0.f, 0.f, 0.f, 0.f};
        const int kmax = (16 * w + 15) >> 5;
        const bf16* wrow = Wsb + ((size_t)g * 128 + 16 * w + (lane & 15)) * 128 + 8 * (lane >> 4);
        const int i16 = lane & 15, gidx = lane >> 4;
#pragma unroll
        for (int ks = 0; ks < 4; ++ks) if (ks <= kmax) {
            const bf16x8 wf = *(const bf16x8*)(wrow + 32 * ks);
            LAS unsigned char* vb = vt + (32 * ks + 8 * gidx + (i16 >> 2)) * GT_STRIDE + (4 * (i16 & 3)) * 2;
#pragma unroll
            for (int nt = 0; nt < 8; ++nt) {
                const s16x4 lo = __builtin_bit_cast(s16x4, __builtin_amdgcn_ds_read_tr16_b64_v4i16((LAS s16x4*)(vb + nt * 32)));
                const s16x4 hi = __builtin_bit_cast(s16x4, __builtin_amdgcn_ds_read_tr16_b64_v4i16((LAS s16x4*)(vb + nt * 32 + 4 * GT_STRIDE)));
                const bf16x8 vf = {lo[0], lo[1], lo[2], lo[3], hi[0], hi[1], hi[2], hi[3]};
                acc[nt] = __builtin_amdgcn_mfma_f32_16x16x32_bf16(vf, wf, acc[nt], 0, 0, 0);
            }
        }
        { const int tl = 16 * w + (lane & 15); const float bst = bs[g * 128 + tl]; const size_t ro = (size_t)(row0 + tl) * DM + g * 128 + 4 * (lane >> 4);
          v2u ux[8]; f32x4 gg[8];
#pragma unroll
          for (int nt = 0; nt < 8; ++nt) { ux[nt] = *(const v2u*)(U + ro + nt * 16); gg[nt] = *(const f32x4*)(gv + g * 128 + 4 * (lane >> 4) + nt * 16); }
          asm volatile("" ::: "memory");
#pragma unroll
          for (int nt = 0; nt < 8; ++nt) { const size_t o = ro + nt * 16;
              v2u r; r.x = pk2(bf_lo(ux[nt].x) * (acc[nt][0] * gg[nt].x + bst), bf_hi(ux[nt].x) * (acc[nt][1] * gg[nt].y + bst)); r.y = pk2(bf_lo(ux[nt].y) * (acc[nt][2] * gg[nt].z + bst), bf_hi(ux[nt].y) * (acc[nt][3] * gg[nt].w + bst));
              *(v2u*)(Uout + o) = r; } }
        __syncthreads();
    }
    if (blockIdx.x < NS) { const int r = blockIdx.x; const float* usu = (const float*)(F.ws + WS_USU) + r * DM; const float* vsf = (const float*)(F.ws + WS_VSF) + r * DM;
        bf16* uss = (bf16*)(F.ws + WS_USS) + r * DM; float* av = F.out + O_AV + (size_t)(layer * NS + r) * DM; const float* Ws = INF(9) + (size_t)layer * 8 * 128 * 128;
        LAS float* red = (LAS float*)F.lds;
        const float v0 = vsf[tid], v1 = vsf[tid + 512]; float s = wave_sum(v0 * v0 + v1 * v1);
        if (lane == 0) red[w] = s;
        __syncthreads();
        float tot = 0.f;
#pragma unroll
        for (int i = 0; i < 8; ++i) tot += red[i];
        const float rstd = rsqrtf(tot * (1.f / DM) + EPS);
#pragma unroll
        for (int h = 0; h < 2; ++h) { const int c = tid + 512 * h, g = c >> 7; const float vn = (h ? v1 : v0) * rstd * gv[c]; av[c] = vn;
            const float sg = Ws[(size_t)g * 128 * 128] * vn + bs[g * 128]; uss[c] = (bf16)(pk2(usu[c] * sg, 0.f) & 0xffffu); }
        __syncthreads();
    }
}

namespace nsa {
constexpr int KS = 144, VS = 192;
constexpr int KBUF = 64 * KS, VBUF = 64 * VS;
constexpr int L_K = 0, L_V = 2 * KBUF, L_IMPA = L_V + 2 * VBUF, IMP_LD = 132, L_IMPB = L_IMPA + 64 * IMP_LD * 4, L_K2 = 0, KBUF2 = 128 * KS, L_V2 = 2 * KBUF2, VBUF2 = 128 * VS, L_STASH = L_V2 + 2 * VBUF2, L_SELM = L_STASH + 8 * 4096, L_END = L_SELM + 64 * 16;
static_assert(L_SELM >= L_IMPB + 64 * IMP_LD * 4, "selection masks clear of the importance tables");
static_assert(L_END <= LDSCTL_OFF, "attention LDS map");
constexpr float NEG = -1e30f;
struct TileRegs { v4u k, v; };
__device__ __forceinline__ TileRegs tile_load(const bf16* Kp, const bf16* Vp, int stride, int row0, int rmax, int tid) {
    int r = row0 + (tid >> 3); r = r < 0 ? 0 : (r > rmax ? rmax : r); const int ch = tid & 7; TileRegs t;
    t.k = *(const v4u*)(Kp + (size_t)r * stride + ch * 8); t.v = *(const v4u*)(Vp + (size_t)r * stride + ch * 8); return t;
}
__device__ __forceinline__ void tile_store(LAS unsigned char* lds, int buf, const TileRegs& t, int tid) {
    const int r = tid >> 3, ch = tid & 7;
    *(LAS v4u*)(lds + L_K + buf * KBUF + r * KS + ch * 16) = t.k;
    *(LAS v4u*)(lds + L_V + buf * VBUF + r * VS + ch * 16) = t.v;
}
__device__ __forceinline__ void load_k_frags(bf16x8 (&kf)[8], const LAS unsigned char* kb, int r32, int hi) {
    const LAS unsigned char* ka = kb + r32 * KS + hi * 16;
#pragma unroll
    for (int d0 = 0; d0 < 4; ++d0) { kf[2 * d0] = *(const LAS bf16x8*)(ka + d0 * 32); kf[2 * d0 + 1] = *(const LAS bf16x8*)(ka + 32 * KS + d0 * 32); }
}
template <int HALF>
__device__ __forceinline__ void load_v_frags(bf16x8 (&vf)[8], const LAS unsigned char* vb, int lane) {
    const int g4 = lane >> 4, h = g4 >> 1, cb = g4 & 1, i = lane & 15;
    const LAS unsigned char* va = vb + (4 * h + (i >> 2)) * VS + (16 * cb + 4 * (i & 3)) * 2;
#pragma unroll
    for (int ks = 2 * HALF; ks < 2 * HALF + 2; ++ks)
#pragma unroll
        for (int db = 0; db < 2; ++db) { const LAS unsigned char* a = va + 16 * ks * VS + 64 * db;
            const s16x4 lo = __builtin_bit_cast(s16x4, __builtin_amdgcn_ds_read_tr16_b64_v4i16((LAS s16x4*)(a)));
            const s16x4 hi4 = __builtin_bit_cast(s16x4, __builtin_amdgcn_ds_read_tr16_b64_v4i16((LAS s16x4*)(a + 8 * VS)));
            vf[2 * ks + db] = (bf16x8){lo[0], lo[1], lo[2], lo[3], hi4[0], hi4[1], hi4[2], hi4[3]}; }
}
__device__ __forceinline__ void qk_mma(f32x16& p0, f32x16& p1, const bf16x8 (&kf)[8], const bf16x8 (&qr)[4], float m) {
    const f32x16 z = {0.f, 0.f, 0.f, 0.f, 0.f, 0.f, 0.f, 0.f, 0.f, 0.f, 0.f, 0.f, 0.f, 0.f, 0.f, 0.f};
    p0 = __builtin_amdgcn_mfma_f32_32x32x16_bf16(kf[0], qr[0], z, 0, 0, 0); p1 = __builtin_amdgcn_mfma_f32_32x32x16_bf16(kf[1], qr[0], z, 0, 0, 0);
#pragma unroll
    for (int d0 = 1; d0 < 4; ++d0) { p0 = __builtin_amdgcn_mfma_f32_32x32x16_bf16(kf[2 * d0], qr[d0], p0, 0, 0, 0); p1 = __builtin_amdgcn_mfma_f32_32x32x16_bf16(kf[2 * d0 + 1], qr[d0], p1, 0, 0, 0); }
    if (__any(m != 0.f)) {
#pragma unroll
        for (int r = 0; r < 16; ++r) { p0[r] -= m; p1[r] -= m; } }
}
__device__ __forceinline__ void mask_tile(f32x16& p0, f32x16& p1, int key0, int lo, int hi_lim, bool rowsel, int hi) {
    const int kb = key0 + 4 * hi;
#pragma unroll
    for (int r = 0; r < 16; ++r) { const int k = kb + (r & 3) + 8 * (r >> 2);
        p0[r] = (rowsel && k >= lo && k <= hi_lim) ? p0[r] : NEG;
        p1[r] = (rowsel && k + 32 >= lo && k + 32 <= hi_lim) ? p1[r] : NEG; }
}
__device__ __forceinline__ float tile_rowmax(const f32x16& p0, const f32x16& p1) {
    float a = fmaxf(p0[0], p1[0]);
#pragma unroll
    for (int r = 1; r < 16; ++r) a = fmaxf(a, fmaxf(p0[r], p1[r]));
    return swap_max(a);
}
__device__ __forceinline__ void pv_mma(f32x16& o0, f32x16& o1, const bf16x8 (&vf)[8], const f32x16& p0, const f32x16& p1, unsigned amask) {
#pragma unroll
    for (int hh = 0; hh < 2; ++hh)
#pragma unroll
        for (int s = 0; s < 2; ++s) {
            v4u pw;
            if (hh == 0) { pw.x = pk2(p0[8 * s + 0], p0[8 * s + 1]); pw.y = pk2(p0[8 * s + 2], p0[8 * s + 3]); pw.z = pk2(p0[8 * s + 4], p0[8 * s + 5]); pw.w = pk2(p0[8 * s + 6], p0[8 * s + 7]); }
            else         { pw.x = pk2(p1[8 * s + 0], p1[8 * s + 1]); pw.y = pk2(p1[8 * s + 2], p1[8 * s + 3]); pw.z = pk2(p1[8 * s + 4], p1[8 * s + 5]); pw.w = pk2(p1[8 * s + 6], p1[8 * s + 7]); }
            pw.x &= amask; pw.y &= amask; pw.z &= amask; pw.w &= amask;
            const bf16x8 pb = __builtin_bit_cast(bf16x8, pw);
            o0 = __builtin_amdgcn_mfma_f32_32x32x16_bf16(vf[2 * (2 * hh + s)], pb, o0, 0, 0, 0);
            o1 = __builtin_amdgcn_mfma_f32_32x32x16_bf16(vf[2 * (2 * hh + s) + 1], pb, o1, 0, 0, 0);
        }
}
__device__ __forceinline__ float soft_tile(f32x16& p0, f32x16& p1) {
    float s0 = 0.f, s1 = 0.f;
#pragma unroll
    for (int r = 0; r < 16; ++r) { p0[r] = fast_exp2(p0[r]); p1[r] = fast_exp2(p1[r]); s0 += p0[r]; s1 += p1[r]; }
    return s0 + s1;
}
constexpr float L_BIG = 1048576.f;
template <bool WITH_O>
__device__ __forceinline__ void ref_shift(float& m, float& l, f32x16& o0, f32x16& o1) {
    const float lm = swap_max(l);
    if (__any(lm > L_BIG)) { const float d = lm > L_BIG ? 20.f : 0.f, alpha = lm > L_BIG ? (1.f / L_BIG) : 1.f; m += d; l *= alpha;
        if (WITH_O) {
#pragma unroll
            for (int r = 0; r < 16; ++r) { o0[r] *= alpha; o1[r] *= alpha; } } }
}
template <bool MASKED>
__device__ __forceinline__ void att_step(const LAS unsigned char* kb, const LAS unsigned char* vb, const bf16x8 (&qr)[4], float& m, float& l, f32x16& o0, f32x16& o1,
                                         int key0, int lo, int hi_lim, bool rsel, int r32, int hi, int lane) {
    f32x16 p0, p1; bf16x8 kf[8], vf[8];
    load_k_frags(kf, kb, r32, hi); load_v_frags<0>(vf, vb, lane);
    __builtin_amdgcn_sched_barrier(0);
    qk_mma(p0, p1, kf, qr, m);
    __builtin_amdgcn_sched_barrier(0);
    load_v_frags<1>(vf, vb, lane);
    __builtin_amdgcn_sched_barrier(0);
    if (MASKED) mask_tile(p0, p1, key0, lo, hi_lim, rsel, hi);
    float s = soft_tile(p0, p1);
    if (!MASKED) s = rsel ? s : 0.f;
    l += s;
    pv_mma(o0, o1, vf, p0, p1, (MASKED || rsel) ? 0xffffffffu : 0u);
    ref_shift<true>(m, l, o0, o1);
}
#define NSA_SB __builtin_amdgcn_sched_barrier(0)
#define NSA_EXP4(P, B, S) do { P[(B)] = fast_exp2(P[(B)]); P[(B) + 1] = fast_exp2(P[(B) + 1]); P[(B) + 2] = fast_exp2(P[(B) + 2]); P[(B) + 3] = fast_exp2(P[(B) + 3]); S += (P[(B)] + P[(B) + 1]) + (P[(B) + 2] + P[(B) + 3]); } while (0)
#define NSA_PACK8(P, B, W, MASK) do { W.x = pk2(P[(B) + 0], P[(B) + 1]) & (MASK); W.y = pk2(P[(B) + 2], P[(B) + 3]) & (MASK); W.z = pk2(P[(B) + 4], P[(B) + 5]) & (MASK); W.w = pk2(P[(B) + 6], P[(B) + 7]) & (MASK); } while (0)
#define NSA_MF(D, A, Bq) D = __builtin_amdgcn_mfma_f32_32x32x16_bf16(A, Bq, D, 0, 0, 0)
#define NSA_PVS(VF, W, I) do { const bf16x8 pb_ = __builtin_bit_cast(bf16x8, W); NSA_MF(o0, VF[2 * (I)], pb_); NSA_MF(o1, VF[2 * (I) + 1], pb_); } while (0)
__device__ __forceinline__ void att_step2(const LAS unsigned char* kba, const LAS unsigned char* vba, const LAS unsigned char* kbb, const LAS unsigned char* vbb, const bf16x8 (&qr)[4],
                                          float& m, float& l, f32x16& o0, f32x16& o1, bool rsela, bool rselb, int r32, int hi, int lane) {
    f32x16 pa0, pa1, pb0, pb1; bf16x8 kf[8], vfa[8], vfb[8];
    const f32x16 z = {0.f, 0.f, 0.f, 0.f, 0.f, 0.f, 0.f, 0.f, 0.f, 0.f, 0.f, 0.f, 0.f, 0.f, 0.f, 0.f};
    const unsigned ma = rsela ? 0xffffffffu : 0u, mb = rselb ? 0xffffffffu : 0u;
    const LAS unsigned char* kab = kbb + r32 * KS + hi * 16;
    load_k_frags(kf, kba, r32, hi);
    NSA_SB;
    pa0 = __builtin_amdgcn_mfma_f32_32x32x16_bf16(kf[0], qr[0], z, 0, 0, 0); pa1 = __builtin_amdgcn_mfma_f32_32x32x16_bf16(kf[1], qr[0], z, 0, 0, 0);
    NSA_MF(pa0, kf[2], qr[1]); NSA_MF(pa1, kf[3], qr[1]); NSA_MF(pa0, kf[4], qr[2]); NSA_MF(pa1, kf[5], qr[2]); NSA_MF(pa0, kf[6], qr[3]); NSA_MF(pa1, kf[7], qr[3]);
    NSA_SB;
#pragma unroll
    for (int d0 = 0; d0 < 4; ++d0) kf[2 * d0] = *(const LAS bf16x8*)(kab + d0 * 32);
    NSA_SB;
    float sa0 = 0.f, sb0 = 0.f; v4u wa0, wa1, wa2, wa3, wb0, wb1, wb2, wb3;
    pb0 = __builtin_amdgcn_mfma_f32_32x32x16_bf16(kf[0], qr[0], z, 0, 0, 0); NSA_SB; NSA_EXP4(pa0, 0, sa0); NSA_SB;
    NSA_MF(pb0, kf[2], qr[1]); NSA_SB; NSA_EXP4(pa0, 4, sa0); NSA_PACK8(pa0, 0, wa0, ma); NSA_SB;
#pragma unroll
    for (int d0 = 0; d0 < 4; ++d0) kf[2 * d0 + 1] = *(const LAS bf16x8*)(kab + 32 * KS + d0 * 32);
    NSA_SB;
    NSA_MF(pb0, kf[4], qr[2]); NSA_SB; NSA_EXP4(pa0, 8, sa0); NSA_SB;
    NSA_MF(pb0, kf[6], qr[3]); NSA_SB; NSA_EXP4(pa0, 12, sa0); NSA_PACK8(pa0, 8, wa1, ma); NSA_SB;
    pb1 = __builtin_amdgcn_mfma_f32_32x32x16_bf16(kf[1], qr[0], z, 0, 0, 0); NSA_SB; NSA_EXP4(pa1, 0, sa0); NSA_SB;
    NSA_MF(pb1, kf[3], qr[1]); NSA_SB; NSA_EXP4(pa1, 4, sa0); NSA_PACK8(pa1, 0, wa2, ma); NSA_SB;
    NSA_MF(pb1, kf[5], qr[2]); NSA_SB; NSA_EXP4(pa1, 8, sa0); NSA_SB;
    NSA_MF(pb1, kf[7], qr[3]); NSA_SB; NSA_EXP4(pa1, 12, sa0); NSA_PACK8(pa1, 8, wa3, ma); NSA_SB;
    load_v_frags<0>(vfa, vba, lane);
    NSA_SB;
    NSA_PVS(vfa, wa0, 0); NSA_SB; load_v_frags<1>(vfa, vba, lane); NSA_EXP4(pb0, 0, sb0); NSA_EXP4(pb0, 4, sb0); NSA_PACK8(pb0, 0, wb0, mb); NSA_SB;
    NSA_PVS(vfa, wa1, 1); NSA_SB; NSA_EXP4(pb0, 8, sb0); NSA_EXP4(pb0, 12, sb0); NSA_PACK8(pb0, 8, wb1, mb); NSA_SB;
    NSA_PVS(vfa, wa2, 2); NSA_SB; load_v_frags<0>(vfb, vbb, lane); NSA_EXP4(pb1, 0, sb0); NSA_EXP4(pb1, 4, sb0); NSA_PACK8(pb1, 0, wb2, mb); NSA_SB;
    NSA_PVS(vfa, wa3, 3); NSA_SB; load_v_frags<1>(vfb, vbb, lane); NSA_EXP4(pb1, 8, sb0); NSA_EXP4(pb1, 12, sb0); NSA_PACK8(pb1, 8, wb3, mb); NSA_SB;
    NSA_PVS(vfb, wb0, 0); NSA_PVS(vfb, wb1, 1); NSA_PVS(vfb, wb2, 2); NSA_PVS(vfb, wb3, 3);
    NSA_SB;
    l += (rsela ? sa0 : 0.f) + (rselb ? sb0 : 0.f);
    ref_shift<true>(m, l, o0, o1);
}
__device__ __forceinline__ void topk_finish(bool c0, bool c1, unsigned u0, unsigned u1, unsigned T, bool exact, int need, int lane, bool& s0, bool& s1) {
    if (exact) { s0 = c0 && u0 >= T; s1 = c1 && u1 >= T; return; }
    const bool g0 = c0 && u0 > T, g1 = c1 && u1 > T, e0 = c0 && u0 == T, e1 = c1 && u1 == T;
    const int rem = need - (__popcll(__ballot(g0)) + __popcll(__ballot(g1)));
    const unsigned long long be0 = __ballot(e0), be1 = __ballot(e1), below = (1ull << lane) - 1ull;
    const int r0 = __popcll(be0 & below), r1 = __popcll(be0) + __popcll(be1 & below);
    s0 = g0 || (e0 && r0 < rem); s1 = g1 || (e1 && r1 < rem);
}
__device__ __forceinline__ void topk_select2(bool c0a, bool c1a, unsigned u0a, unsigned u1a, bool c0b, bool c1b, unsigned u0b, unsigned u1b, int need, int lane, bool& s0a, bool& s1a, bool& s0b, bool& s1b) {
    const int ncand = __popcll(__ballot(c0a)) + __popcll(__ballot(c1a));
    if (ncand <= need) { s0a = c0a; s1a = c1a; s0b = c0b; s1b = c1b; return; }
    u0a = c0a ? u0a : 0u; u1a = c1a ? u1a : 0u; u0b = c0b ? u0b : 0u; u1b = c1b ? u1b : 0u;
    unsigned Ta = 0u, Tb = 0u; bool xa = false, xb = false;
    for (int bit = 30; bit >= 0; --bit) {
        const unsigned Tna = Ta | (1u << bit), Tnb = Tb | (1u << bit);
        const int ca = __popcll(__ballot(u0a >= Tna)) + __popcll(__ballot(u1a >= Tna)), cb = __popcll(__ballot(u0b >= Tnb)) + __popcll(__ballot(u1b >= Tnb));
        if (!xa) { if (ca >= need) Ta = Tna; xa = ca == need; }
        if (!xb) { if (cb >= need) Tb = Tnb; xb = cb == need; }
        if (xa && xb) break;
    }
    topk_finish(c0a, c1a, u0a, u1a, Ta, xa, need, lane, s0a, s1a);
    topk_finish(c0b, c1b, u0b, u1b, Tb, xb, need, lane, s0b, s1b);
}
__device__ __forceinline__ void topk_select(bool c0, bool c1, unsigned u0, unsigned u1, int need, int lane, bool& s0, bool& s1) {
    bool d0, d1; topk_select2(c0, c1, u0, u1, c0, c1, u0, u1, need, lane, s0, s1, d0, d1);
}

struct TileSrc { const bf16* K; const bf16* V; int stride, row0, rmax; };
struct Tile2Regs { v4u k0, k1, v0, v1; };
__device__ __forceinline__ Tile2Regs tile2_load(const bf16* Kp, const bf16* Vp, int row0, int tid) {
    int r = row0 + (tid >> 2); r = r > SEQ - 1 ? SEQ - 1 : r; const int c = (tid & 3) * 16; Tile2Regs t;
    const bf16* kp = Kp + (size_t)r * 512 + c; const bf16* vp = Vp + (size_t)r * 512 + c;
    t.k0 = *(const v4u*)kp; t.k1 = *(const v4u*)(kp + 8); t.v0 = *(const v4u*)vp; t.v1 = *(const v4u*)(vp + 8); return t;
}
__device__ __forceinline__ void tile2_store(LAS unsigned char* lds, int buf, const Tile2Regs& t, int tid) {
    const int r = tid >> 2, c = (tid & 3) * 32;
    *(LAS v4u*)(lds + L_K2 + buf * KBUF2 + r * KS + c) = t.k0; *(LAS v4u*)(lds + L_K2 + buf * KBUF2 + r * KS + c + 16) = t.k1;
    *(LAS v4u*)(lds + L_V2 + buf * VBUF2 + r * VS + c) = t.v0; *(LAS v4u*)(lds + L_V2 + buf * VBUF2 + r * VS + c + 16) = t.v1;
}
__device__ __forceinline__ void nsa_unit(const bf16* __restrict__ Q, const float* __restrict__ gates, const bf16* __restrict__ kc, const bf16* __restrict__ vc,
                                         const bf16* __restrict__ ksel, const bf16* __restrict__ kwin, bf16* __restrict__ O, int b, int g, int qb, LAS unsigned char* lds) {
    int tid_l = threadIdx.x; asm volatile("" : "+v"(tid_l)); const int tid = tid_l, lane = tid & 63, r32 = lane & 31, hi = lane >> 5, wid = __builtin_amdgcn_readfirstlane(tid >> 6);
    const int t0 = qb * 64, cur = qb, ql = 8 * wid + (r32 >> 2), tq = t0 + ql, head = 4 * g + (r32 & 3);
    const size_t qrow = (size_t)b * SEQ + tq;
    bf16x8 qr[4];
#pragma unroll
    for (int d0 = 0; d0 < 4; ++d0) qr[d0] = *(const bf16x8*)(Q + qrow * DM + head * 64 + 16 * d0 + 8 * hi);
    f32x16 ob0, ob1;
    LAS unsigned* stash = (LAS unsigned*)(lds + L_STASH) + wid * 1024 + lane;
    LAS float* impA = (LAS float*)(lds + L_IMPA); LAS float* impB = (LAS float*)(lds + L_IMPB); LAS unsigned long long* selm = (LAS unsigned long long*)(lds + L_SELM);
    const int nct = (((t0 + 32) >> 4) >> 6) + 1, cmax_q = (tq - 31) >> 4, cmax_w = (t0 + 8 * wid - 31) >> 4;
    const bf16* Kc = kc + (size_t)b * 512 * 256 + g * 64; const bf16* Vc = vc + (size_t)b * 512 * 256 + g * 64;
    float m = 0.f, l = 0.f, inv = 0.f;
#pragma unroll
    for (int r = 0; r < 16; ++r) { ob0[r] = 0.f; ob1[r] = 0.f; }
    { const int nd1 = (nct + 1) >> 1; TileRegs r1;
      r1 = tile_load(Kc, Kc + 64 * 256, 256, 0, 511, tid);
      { const int r = tid >> 3, ch = tid & 7; *(LAS v4u*)(lds + L_K + r * KS + ch * 16) = r1.k; *(LAS v4u*)(lds + L_V + r * KS + ch * 16) = r1.v; }
      __syncthreads();
      for (int s = 0; s < nd1; ++s) { const int buf = s & 1, ta = 2 * s, tb = ta + 1;
        if (s + 1 < nd1) r1 = tile_load(Kc, Kc + 64 * 256, 256, 128 * (s + 1), 511, tid); else r1 = tile_load(Kc, Vc, 256, 0, 511, tid);
        const LAS unsigned char* kba = lds + L_K + buf * KBUF; const LAS unsigned char* kbb = lds + L_V + buf * VBUF;
        { f32x16 pa0, pa1; bf16x8 kf[8]; load_k_frags(kf, kba, r32, hi); __builtin_amdgcn_sched_barrier(0); qk_mma(pa0, pa1, kf, qr, m); __builtin_amdgcn_sched_barrier(0);
          if (tb < nct) { f32x16 pb0, pb1; load_k_frags(kf, kbb, r32, hi); __builtin_amdgcn_sched_barrier(0); qk_mma(pb0, pb1, kf, qr, m); __builtin_amdgcn_sched_barrier(0);
              if (64 * ta + 63 > cmax_w) { asm volatile("; boundary tile" ::: "memory"); mask_tile(pa0, pa1, 64 * ta, 0, cmax_q, true, hi); }
              if (64 * tb + 63 > cmax_w) { asm volatile("; boundary tile" ::: "memory"); mask_tile(pb0, pb1, 64 * tb, 0, cmax_q, true, hi); }
              const float sa_ = soft_tile(pa0, pa1); const float sb_ = soft_tile(pb0, pb1); l += sa_ + sb_; }
          else { if (64 * ta + 63 > cmax_w) { asm volatile("; boundary tile" ::: "memory"); mask_tile(pa0, pa1, 64 * ta, 0, cmax_q, true, hi); }
              const float sa_ = soft_tile(pa0, pa1); l += sa_; }
          ref_shift<false>(m, l, ob0, ob1); }
        if (s + 1 < nd1) { const int r = tid >> 3, ch = tid & 7; *(LAS v4u*)(lds + L_K + (buf ^ 1) * KBUF + r * KS + ch * 16) = r1.k; *(LAS v4u*)(lds + L_V + (buf ^ 1) * VBUF + r * KS + ch * 16) = r1.v; }
        else tile_store(lds, buf ^ 1, r1, tid);
        __syncthreads(); }
      l = swap_sum(l); inv = l > 0.f ? 1.f / l : 0.f;
      for (int ti = 0; ti < nct; ++ti) { const int buf = (nd1 + ti) & 1;
        if (ti + 1 < nct) r1 = tile_load(Kc, Vc, 256, 64 * (ti + 1), 511, tid);
        const LAS unsigned char* kb = lds + L_K + buf * KBUF; const LAS unsigned char* vb = lds + L_V + buf * VBUF;
        { f32x16 p0, p1; bf16x8 kf[8], vf[8]; load_k_frags(kf, kb, r32, hi); load_v_frags<0>(vf, vb, lane); __builtin_amdgcn_sched_barrier(0); qk_mma(p0, p1, kf, qr, m); __builtin_amdgcn_sched_barrier(0); load_v_frags<1>(vf, vb, lane); __builtin_amdgcn_sched_barrier(0);
            if (64 * ti + 63 > cmax_w) { asm volatile("; boundary tile" ::: "memory"); mask_tile(p0, p1, 64 * ti, 0, cmax_q, true, hi); }
#pragma unroll
            for (int r = 0; r < 16; ++r) { p0[r] = fast_exp2(p0[r]) * inv; p1[r] = fast_exp2(p1[r]) * inv; }
#pragma unroll
            for (int hh = 0; hh < 2; ++hh)
#pragma unroll
                for (int gi = 0; gi < 4; ++gi) { float P[4];
#pragma unroll
                    for (int e = 0; e < 4; ++e) P[e] = quad_sum(hh ? p1[4 * gi + e] : p0[4 * gi + e]);
                    if ((r32 & 3) == 0) { const int j = 16 * ti + 8 * hh + 2 * gi + hi; impA[ql * IMP_LD + j] = 2.f * (P[0] + P[1] + P[2]) + P[3]; impB[ql * IMP_LD + j + 1] = P[3]; } }
            pv_mma(ob0, ob1, vf, p0, p1, 0xffffffffu); }
        if (ti + 1 < nct) tile_store(lds, buf ^ 1, r1, tid);
        __syncthreads(); } }
    const bf16* Ks = ksel + (size_t)b * SEQ * 512 + g * 64; const bf16* Kw = kwin + (size_t)b * SEQ * 512 + g * 64;
    Tile2Regs r2 = tile2_load(Ks, Ks + 256, 0, tid);
    unsigned long long wlo = 0ull, whi = 0ull;
    { const int nforced = cur >= 2 ? 3 : cur + 1, need = 16 - nforced;
      for (int qi = 0; qi < 8; qi += 2) { const int qa = 8 * wid + qi, qb_ = qa + 1; const int j0 = lane, j1 = lane + 64;
          const bool c0 = j0 >= 1 && j0 <= cur - 2, c1 = j1 <= cur - 2;
          const float v0a = c0 ? impA[qa * IMP_LD + j0] + impB[qa * IMP_LD + j0] : 0.f, v1a = c1 ? impA[qa * IMP_LD + j1] + impB[qa * IMP_LD + j1] : 0.f;
          const float v0b = c0 ? impA[qb_ * IMP_LD + j0] + impB[qb_ * IMP_LD + j0] : 0.f, v1b = c1 ? impA[qb_ * IMP_LD + j1] + impB[qb_ * IMP_LD + j1] : 0.f;
          bool s0a, s1a, s0b, s1b; topk_select2(c0, c1, __float_as_uint(v0a), __float_as_uint(v1a), c0, c1, __float_as_uint(v0b), __float_as_uint(v1b), need, lane, s0a, s1a, s0b, s1b);
          const bool f0 = j0 == 0 || j0 == cur || j0 == cur - 1, f1 = j1 == cur || j1 == cur - 1;
          const unsigned long long a0 = __ballot(s0a || f0), a1 = __ballot(s1a || f1), b0 = __ballot(s0b || f0), b1 = __ballot(s1b || f1);
          if (lane == 0) { selm[qa * 2 + 0] = a0; selm[qa * 2 + 1] = a1; selm[qb_ * 2 + 0] = b0; selm[qb_ * 2 + 1] = b1; } }
      __syncthreads();
      tile2_store(lds, 0, r2, tid);
#pragma unroll
      for (int i = 0; i < 8; ++i) { wlo |= selm[(8 * wid + i) * 2 + 0]; whi |= selm[(8 * wid + i) * 2 + 1]; }
      wlo = ((unsigned long long)__builtin_amdgcn_readfirstlane((unsigned)(wlo >> 32)) << 32) | (unsigned)__builtin_amdgcn_readfirstlane((unsigned)wlo);
      whi = ((unsigned long long)__builtin_amdgcn_readfirstlane((unsigned)(whi >> 32)) << 32) | (unsigned)__builtin_amdgcn_readfirstlane((unsigned)whi);
      const float gt0 = gates[qrow * 48 + head * 3 + 0];
#pragma unroll
      for (int r = 0; r < 16; ++r) { stash[64 * r] = pk2(gt0 * ob0[r], gt0 * ob1[r]); ob0[r] = 0.f; ob1[r] = 0.f; }
      m = 0.f; l = 0.f;
      __syncthreads(); }
    { const int nd = (cur >> 1) + 1;
      for (int dt = 0; dt < nd; ++dt) { const int buf = dt & 1;
          if (dt + 1 < nd) r2 = tile2_load(Ks, Ks + 256, 128 * (dt + 1), tid);
          { const int ja = 2 * dt, jb = ja + 1;
            const bool na = (((ja < 64 ? wlo : whi) >> (ja & 63)) & 1ull) != 0ull, nb = jb < cur && (((jb < 64 ? wlo : whi) >> (jb & 63)) & 1ull) != 0ull;
            if (na && nb && !__any(m != 0.f)) { const unsigned long long mq = selm[ql * 2 + (ja >> 6)]; const bool rsa = ((mq >> (ja & 63)) & 1ull) != 0ull, rsb = ((mq >> (jb & 63)) & 1ull) != 0ull;
                att_step2(lds + L_K2 + buf * KBUF2, lds + L_V2 + buf * VBUF2, lds + L_K2 + buf * KBUF2 + 64 * KS, lds + L_V2 + buf * VBUF2 + 64 * VS, qr, m, l, ob0, ob1, rsa, rsb, r32, hi, lane); }
            else {
#pragma unroll
          for (int sub = 0; sub < 2; ++sub) { const int j = 2 * dt + sub;
              const bool wneed = j <= cur && (((j < 64 ? wlo : whi) >> (j & 63)) & 1ull) != 0ull;
              if (wneed) { const bool rsel = ((selm[ql * 2 + (j >> 6)] >> (j & 63)) & 1ull) != 0ull;
                  const LAS unsigned char* kb = lds + L_K2 + buf * KBUF2 + sub * 64 * KS; const LAS unsigned char* vb = lds + L_V2 + buf * VBUF2 + sub * 64 * VS;
                  if (j == cur) att_step<true>(kb, vb, qr, m, l, ob0, ob1, 64 * j, 0, tq, rsel, r32, hi, lane);
                  else att_step<false>(kb, vb, qr, m, l, ob0, ob1, 64 * j, 0, tq, rsel, r32, hi, lane); } } } }
          if (dt + 1 < nd) tile2_store(lds, buf ^ 1, r2, tid);
          __syncthreads(); }
      int tidB_l = threadIdx.x; asm volatile("" : "+v"(tidB_l));
      const int laneB = tidB_l & 63, r32B = laneB & 31, widB = __builtin_amdgcn_readfirstlane(tidB_l >> 6), headB = 4 * g + (r32B & 3); const size_t qrowB = (size_t)b * SEQ + t0 + 8 * widB + (r32B >> 2);
      l = swap_sum(l); const float gt1 = gates[qrowB * 48 + headB * 3 + 1]; const float sc = l > 0.f ? gt1 / l : 0.f;
#pragma unroll
      for (int r = 0; r < 16; ++r) { const unsigned u = stash[64 * r]; stash[64 * r] = pk2(bf_lo(u) + sc * ob0[r], bf_hi(u) + sc * ob1[r]); ob0[r] = 0.f; ob1[r] = 0.f; }
      m = 0.f; l = 0.f; }
    int tidC_l = threadIdx.x; asm volatile("" : "+v"(tidC_l));
    const int tidC = tidC_l, laneC = tidC & 63, r32C = laneC & 31, hiC = laneC >> 5, widC = __builtin_amdgcn_readfirstlane(tidC >> 6), tqC = t0 + 8 * widC + (r32C >> 2), headC = 4 * g + (r32C & 3); const size_t qrowC = (size_t)b * SEQ + tqC;

    { const int jb = cur >= 8 ? cur - 8 : 0, d0 = jb >> 1, nd = (cur >> 1) - d0 + 1;
      r2 = tile2_load(Kw, Kw + 256, 128 * d0, tidC); tile2_store(lds, 0, r2, tidC);
      __syncthreads();
      for (int dt = 0; dt < nd; ++dt) { const int buf = dt & 1;
          if (dt + 1 < nd) r2 = tile2_load(Kw, Kw + 256, 128 * (d0 + dt + 1), tidC);
#pragma unroll
          for (int sub = 0; sub < 2; ++sub) { const int j = 2 * (d0 + dt) + sub;
              if (j >= jb && j <= cur) {
                  const LAS unsigned char* kb = lds + L_K2 + buf * KBUF2 + sub * 64 * KS; const LAS unsigned char* vb = lds + L_V2 + buf * VBUF2 + sub * 64 * VS;
                  if (j == jb || j == cur) att_step<true>(kb, vb, qr, m, l, ob0, ob1, 64 * j, tqC - 511, tqC, true, r32C, hiC, laneC);
                  else att_step<false>(kb, vb, qr, m, l, ob0, ob1, 64 * j, tqC - 511, tqC, true, r32C, hiC, laneC); } }
          if (dt + 1 < nd) tile2_store(lds, buf ^ 1, r2, tidC);
          __syncthreads(); } }
    { l = swap_sum(l); const float gt2 = gates[qrowC * 48 + headC * 3 + 2]; const float sc = l > 0.f ? gt2 / l : 0.f;
#pragma unroll
      for (int r = 0; r < 16; ++r) { const unsigned u = stash[64 * r]; ob0[r] = bf_lo(u) + sc * ob0[r]; ob1[r] = bf_hi(u) + sc * ob1[r]; } }
    { bf16* orow = O + qrowC * DM + headC * 64 + 4 * hiC;
#pragma unroll
      for (int gi = 0; gi < 4; ++gi) { v2u w; w.x = pk2(ob0[4 * gi], ob0[4 * gi + 1]); w.y = pk2(ob0[4 * gi + 2], ob0[4 * gi + 3]); *(v2u*)(orow + 8 * gi) = w;
          v2u w1; w1.x = pk2(ob1[4 * gi], ob1[4 * gi + 1]); w1.y = pk2(ob1[4 * gi + 2], ob1[4 * gi + 3]); *(v2u*)(orow + 32 + 8 * gi) = w1; } }
    __syncthreads();
}
}

namespace dec {
constexpr int L_SC = 1024, L_PC = 17408, L_RED = 19456, L_OBUF = 19584, L_OFIN = 27776, L_SBASE = 30848, L_NSEL = 30976;
constexpr float NEG = -1e30f;
__device__ __forceinline__ void block_reduce4(float (&v)[4], bool is_max, LAS float* red, int lane, int wave) {
#pragma unroll
    for (int h = 0; h < 4; ++h) v[h] = is_max ? wave_max(v[h]) : wave_sum(v[h]);
    __syncthreads();
    if (lane == 0) {
#pragma unroll
        for (int h = 0; h < 4; ++h) red[wave * 4 + h] = v[h]; }
    __syncthreads();
#pragma unroll
    for (int h = 0; h < 4; ++h) { float a = red[h];
#pragma unroll
        for (int w = 1; w < 8; ++w) a = is_max ? fmaxf(a, red[w * 4 + h]) : a + red[w * 4 + h];
        v[h] = a; }
}
__device__ __forceinline__ void softmax_sc(LAS float* sc, LAS float* red, float (&inv)[4], int tid, int lane, int wave) {
    float mx[4] = {NEG, NEG, NEG, NEG};
    for (int k = tid; k < 1024; k += 512) {
#pragma unroll
        for (int h = 0; h < 4; ++h) mx[h] = fmaxf(mx[h], sc[h * 1024 + k]); }
    block_reduce4(mx, true, red, lane, wave);
    float sm[4] = {0.f, 0.f, 0.f, 0.f};
    for (int k = tid; k < 1024; k += 512) {
#pragma unroll
        for (int h = 0; h < 4; ++h) { const float e = fast_exp2(sc[h * 1024 + k] - mx[h]); sc[h * 1024 + k] = e; sm[h] += e; } }
    block_reduce4(sm, false, red, lane, wave);
#pragma unroll
    for (int h = 0; h < 4; ++h) inv[h] = 1.f / sm[h];
}
struct LdCmp { const bf16* kc; const bf16* vc; int seq, g;
    __device__ __forceinline__ f32x4 operator()(int k, int which, int l16) const { const bf16* p = (which ? vc : kc) + ((size_t)(seq * 512 + k) * 4 + g) * 64 + 4 * l16; const v2u x = *(const v2u*)p; return (f32x4){bf_lo(x.x), bf_hi(x.x), bf_lo(x.y), bf_hi(x.y)}; } };
struct LdSel { const float* csel; const LAS long long* sbase; const float* newrow; int nk;
    __device__ __forceinline__ f32x4 operator()(int k, int which, int l16) const { const float* p = (k < nk - 1) ? csel + sbase[k >> 6] + (size_t)(k & 63) * 512 : newrow; return *(const f32x4*)(p + which * 256 + 4 * l16); } };
struct LdWin { const float* swin; const float* newrow; int seq, g;
    __device__ __forceinline__ f32x4 operator()(int k, int which, int l16) const { const float* p = (k < 511) ? swin + (size_t)(seq * 512 + k + 1) * 512 + g * 64 : newrow; return *(const f32x4*)(p + which * 256 + 4 * l16); } };
template <class Ld>
__device__ __forceinline__ void branch(const Ld& L, int nk, const f32x4 (&q)[4], LAS float* sc, LAS float* red, LAS float* obuf, LAS float* ofin, float (&inv)[4], int tid, int lane, int wave) {
    const int l16 = lane & 15, gq = lane >> 4, nsteps = (nk + 31) >> 5;
    for (int k = tid; k < 4096; k += 512) sc[k] = NEG;
    __syncthreads();
    for (int it0 = 0; it0 < nsteps; it0 += 8) { f32x4 kv[8];
#pragma unroll
        for (int j = 0; j < 8; ++j) { const int k = (it0 + j) * 32 + wave * 4 + gq; kv[j] = (k < nk) ? L(k, 0, l16) : (f32x4){0.f, 0.f, 0.f, 0.f}; }
#pragma unroll
        for (int j = 0; j < 8; ++j) { const int k = (it0 + j) * 32 + wave * 4 + gq; float s[4];
#pragma unroll
            for (int h = 0; h < 4; ++h) { float x = (kv[j].x * q[h].x + kv[j].y * q[h].y) + (kv[j].z * q[h].z + kv[j].w * q[h].w); s[h] = row16_sum(x); }
            if (k < nk && l16 < 4) sc[l16 * 1024 + k] = l16 == 0 ? s[0] : l16 == 1 ? s[1] : l16 == 2 ? s[2] : s[3]; } }
    __syncthreads();
    softmax_sc(sc, red, inv, tid, lane, wave);
    __syncthreads();
    f32x4 acc[4];
#pragma unroll
    for (int h = 0; h < 4; ++h) acc[h] = (f32x4){0.f, 0.f, 0.f, 0.f};
    for (int it0 = 0; it0 < nsteps; it0 += 8) { f32x4 vv[8];
#pragma unroll
        for (int j = 0; j < 8; ++j) { const int k = (it0 + j) * 32 + wave * 4 + gq; vv[j] = (k < nk) ? L(k, 1, l16) : (f32x4){0.f, 0.f, 0.f, 0.f}; }
#pragma unroll
        for (int j = 0; j < 8; ++j) { const int k = (it0 + j) * 32 + wave * 4 + gq; const int kc = k < 1024 ? k : 1023;
#pragma unroll
            for (int h = 0; h < 4; ++h) { const float p = (k < nk) ? sc[h * 1024 + kc] : 0.f; acc[h] += vv[j] * p; } } }
#pragma unroll
    for (int h = 0; h < 4; ++h)
#pragma unroll
        for (int e = 0; e < 4; ++e) { float x = acc[h][e]; x += __shfl_xor(x, 16); x += __shfl_xor(x, 32); acc[h][e] = x; }
    if (gq == 0) {
#pragma unroll
        for (int h = 0; h < 4; ++h) *(LAS f32x4*)(obuf + (wave * 4 + h) * 64 + 4 * l16) = acc[h]; }
    __syncthreads();
    if (tid < 256) { float a = 0.f;
#pragma unroll
        for (int w = 0; w < 8; ++w) a += obuf[w * 256 + tid];
        const int h = tid >> 6; ofin[tid] = a * (h == 0 ? inv[0] : h == 1 ? inv[1] : h == 2 ? inv[2] : inv[3]); }
    __syncthreads();
}
__device__ __forceinline__ void sample_attn_unit(const float* csel, const float* swin, const int* pt, unsigned char* ws, float* out, int seq, int g, LAS unsigned char* lds) {
    int tid_l = threadIdx.x; asm volatile("" : "+v"(tid_l)); const int tid = tid_l, lane = tid & 63, wave = tid >> 6, l16 = lane & 15;
    LAS float* sc = (LAS float*)(lds + L_SC); LAS float* Pc = (LAS float*)(lds + L_PC); LAS float* red = (LAS float*)(lds + L_RED);
    LAS float* obuf = (LAS float*)(lds + L_OBUF); LAS float* ofin = (LAS float*)(lds + L_OFIN); LAS long long* sbase = (LAS long long*)(lds + L_SBASE); LAS int* nselp = (LAS int*)(lds + L_NSEL);
    const float* QS = (const float*)(ws + WS_QS); const float* GS = (const float*)(ws + WS_GS);
    f32x4 q[4];
#pragma unroll
    for (int h = 0; h < 4; ++h) q[h] = *(const f32x4*)(QS + seq * DM + (4 * g + h) * 64 + 4 * l16);
    float inv[4];
    { const LdCmp L{(const bf16*)(ws + WS_KC), (const bf16*)(ws + WS_VC), seq, g}; branch(L, 511, q, sc, red, obuf, ofin, inv, tid, lane, wave); }
    Pc[tid] = tid < 511 ? (sc[tid] * inv[0] + sc[1024 + tid] * inv[1]) + (sc[2048 + tid] * inv[2] + sc[3072 + tid] * inv[3]) : 0.f;
    __syncthreads();
    if (wave == 0) { const int j0 = lane, j1 = lane + 64; const bool c0 = j0 >= 1, c1 = j1 <= 126;
        const float v0 = c0 ? Pc[4 * j0 - 1] + 2.f * (Pc[4 * j0] + Pc[4 * j0 + 1] + Pc[4 * j0 + 2]) + Pc[4 * j0 + 3] : 0.f;
        const float v1 = c1 ? Pc[4 * j1 - 1] + 2.f * (Pc[4 * j1] + Pc[4 * j1 + 1] + Pc[4 * j1 + 2]) + Pc[4 * j1 + 3] : 0.f;
        bool s0, s1; nsa::topk_select(c0, c1, __float_as_uint(v0), __float_as_uint(v1), 13, lane, s0, s1);
        s0 = s0 || j0 == 0; s1 = s1 || j1 == 127;
        unsigned long long b0 = __ballot(s0), b1 = __ballot(s1);
        if (lane == 0) { int n = 0;
            while (b0 && n < 15) { const int j = __builtin_ctzll(b0); b0 &= b0 - 1ull; sbase[n++] = ((long long)pt[seq * 64 + (j >> 1)] * 128 + (j & 1) * 64) * 512 + g * 64; }
            while (b1 && n < 15) { const int j = 64 + __builtin_ctzll(b1); b1 &= b1 - 1ull; sbase[n++] = ((long long)pt[seq * 64 + (j >> 1)] * 128 + (j & 1) * 64) * 512 + g * 64; }
            nselp[0] = n; } }
    __syncthreads();
    { const int nk = nselp[0] * 64 + 1; const LdSel L{csel, sbase, out + O_SELS + seq * 512 + g * 64, nk}; branch(L, nk, q, sc, red, obuf, ofin + 256, inv, tid, lane, wave); }
    { const LdWin L{swin, out + O_WINS + (size_t)(seq * 512 + 511) * 512 + g * 64, seq, g}; branch(L, 512, q, sc, red, obuf, ofin + 512, inv, tid, lane, wave); }
    if (tid < 256) { const int head = 4 * g + (tid >> 6); const float* gp = GS + seq * 48 + head * 3;
        const float o = gp[0] * ofin[tid] + gp[1] * ofin[256 + tid] + gp[2] * ofin[512 + tid];
        ((bf16*)(ws + WS_OS))[seq * DM + head * 64 + (tid & 63)] = (bf16)(pk2(o, 0.f) & 0xffffu); }
    __syncthreads();
}
}

#ifndef ONLY_SITE
#define ONLY_SITE -1
#endif
#define SITE_ON(n) (ONLY_SITE < 0 || ONLY_SITE == (n))
#ifndef PROBE_DUP
#define PROBE_DUP 0
#endif
#define REP(n) for (int rep_ = 0; rep_ < 1 + ((PROBE_DUP >> (n)) & 1); ++rep_)
__global__ void __launch_bounds__(NWAVES * 64, 2) yoco_fwd(Args args) {
    extern __shared__ __attribute__((aligned(16))) unsigned char lds_raw[];
    LAS unsigned char* const lds = (LAS unsigned char*)lds_raw;
    for (int u = threadIdx.x; u < (LDS_BYTES - LDSCTL_OFF) / 4; u += NWAVES * 64) ((LAS unsigned*)(lds + LDSCTL_OFF))[u] = 0u;
    __syncthreads();
    if (threadIdx.x == 0) { LAS unsigned long long* tab = (LAS unsigned long long*)(lds + PTAB_OFF);
#pragma unroll
        for (int i = 0; i < 28; ++i) tab[i] = (unsigned long long)args.in[i];
        tab[28] = (unsigned long long)args.out; tab[29] = (unsigned long long)args.ws; }
    __syncthreads();
    XcdBarrier bar; bar.bar = (unsigned*)((unsigned char*)tab_ptr(lds, 29) + WS_CTL) + CW_BAR; bar.x = 0; bar.st = nullptr;
    if (args.use_bar) bar = xcd_barrier_post(bar.bar, (volatile LAS unsigned*)(lds + MISC_OFF) + 8);
    const int lo = args.ph_lo, hi = args.ph_hi, use_bar = args.use_bar;
    int ph = 0;
#define PH_ON (ph >= lo && ph < hi)
#define PH_END do { if (PH_ON && ph + 1 < hi) { if (use_bar) xcd_barrier(bar); } ++ph; } while (0)
#define MKFRAME Frame F; F.lds = lds; F.MISC = (volatile LAS unsigned*)(lds + MISC_OFF); { int tid_l = threadIdx.x; asm volatile("" : "+v"(tid_l)); F.tid = tid_l; } F.lane = F.tid & 63; F.wave = __builtin_amdgcn_readfirstlane(F.tid >> 6); \
    F.G = gridDim.x; F.gw = blockIdx.x * NWAVES + F.wave; F.NGW = F.G * NWAVES; F.ws = (unsigned char*)tab_ptr(lds, 29); F.out = (float*)tab_ptr(lds, 28); unsigned char* const ws = F.ws; (void)ws

    if (SITE_ON(0) && PH_ON) REP(0) { MKFRAME; prologue_phase(F); }
    PH_END;

    for (int layer = 0; layer < 4; ++layer) {
        if (layer < 2) {
            if (SITE_ON(1) && PH_ON) REP(1) { MKFRAME;
                const bf16* W = (const bf16*)(ws + WS_WUV) + (size_t)layer * 2048 * 1024;
                pg8::Gemm g{(const bf16*)(ws + WS_XN), W, MP, 2048, DM}; pg8::StaticOrder S; S.init(MP, 2048, F.G, (int)blockIdx.x);
                EpiUV E{(bf16*)(ws + WS_U), (bf16*)(ws + WS_V), (float*)(ws + WS_ROWSS), (const float*)(ws + WS_ROWSS2)};
                pg8::gemm_phase<EpiUV, pg8::StaticOrder, true, true>(F.lds, g, S, E);
                SkUV SE{(float*)(ws + WS_USU), (float*)(ws + WS_VSF)};
                skinny_gemm_hs(F.lds, (const float*)(ws + WS_HS), W, 2048, SE);
            }
            PH_END;
            if (SITE_ON(2) && PH_ON) { MKFRAME;
#ifdef PROBE_GATE
                gating_phase(F, layer, (bf16*)(ws + WS_H1));
#endif
                gating_phase(F, layer, (bf16*)(ws + WS_U)); }
            PH_END;
        } else {
            if (SITE_ON(3) && PH_ON) REP(3) { MKFRAME;
                const bool first = layer == 2; const int N = first ? NKVQG : NQG1; const bf16* W = (const bf16*)(ws + (first ? WS_WKVQG : WS_WQG1));
                const float* bg = INF(22) + (layer - 2) * 48;
                pg8::Gemm g{(const bf16*)(ws + WS_XN), W, MP, N, DM}; pg8::StaticOrder S; S.init(MP, N, F.G, (int)blockIdx.x);
                EpiKVQG E{F.out, (bf16*)(ws + WS_ACMP), (bf16*)(ws + WS_KSEL), (bf16*)(ws + WS_KWIN), (bf16*)(ws + WS_Q), (float*)(ws + WS_GATES), bg, first ? 0 : 6, (const float*)(ws + WS_ROWSS2)};
                pg8::gemm_phase<EpiKVQG, pg8::StaticOrder, true, true>(F.lds, g, S, E);
                SkKVQG SE{F.out, (float*)(ws + WS_QS), (float*)(ws + WS_GS), bg, first ? 0 : 1536};
                skinny_gemm_hs(F.lds, (const float*)(ws + WS_HS), W, N, SE);
                if (first) {
                    pg8::Gemm g2{(const bf16*)(ws + WS_ACMP), (const bf16*)(ws + WS_WC1), 2 * ACMP_ROWS, 1024, DM};
                    TBEarlyOrder S2; S2.G = F.G; S2.c = (int)blockIdx.x;
                    EpiTB E2{(bf16*)(ws + WS_TB)};
                    pg8::gemm_phase<EpiTB, TBEarlyOrder, true, true>(F.lds, g2, S2, E2);
                }
            }
            PH_END;
            if (layer == 2) {
                if (SITE_ON(4) && PH_ON) REP(4) { MKFRAME;
                    pg8::Gemm g{(const bf16*)(ws + WS_ACMP), (const bf16*)(ws + WS_WC1F), 2 * ACMP_ROWS, 512, 2048};
                    TBFOrder S; S.G = F.G; S.c = (int)blockIdx.x; S.HB = (const bf16*)(ws + WS_HB); S.W2 = (const bf16*)(ws + WS_WC2); S.KC = (bf16*)(ws + WS_KC); S.VC = (bf16*)(ws + WS_VC);
                    EpiH E{(bf16*)(ws + WS_HB), (const float*)(ws + WS_BIAS1)};
                    pg8::gemm_phase<EpiH, TBFOrder, true, true, 1024, 8192>(F.lds, g, S, E);
                    for (int x = F.gw; x < 512; x += F.NGW) { const int kv = x >> 8, un = 3840 + (x & 255);
                        combine16_tb((const bf16*)(ws + WS_TB + (size_t)kv * WS_TB_STRIDE), (const float*)(ws + WS_BIAS1) + kv * 256, (const bf16*)(ws + WS_WC2) + (size_t)kv * 64 * 256, (bf16*)(ws + (kv ? WS_VC : WS_KC)), un, F.lane); }
                }
                PH_END;
            }
            if (SITE_ON(6) && PH_ON) REP(6) { MKFRAME;
                const bf16* kcp = (const bf16*)(ws + WS_KC) + (size_t)65536 * 64; const bf16* vcp = (const bf16*)(ws + WS_VC) + (size_t)65536 * 64;
                for (int un = blockIdx.x; un < 1024; un += F.G) { const int bx = un & 255, v = (bx & 7) * 32 + (bx >> 3), i = un >> 8, bg = v >> 5, s = v & 31;
                    const int qb = NSA_QB[s * 4 + i];
                    nsa::nsa_unit((const bf16*)(ws + WS_Q), (const float*)(ws + WS_GATES), kcp, vcp, (const bf16*)(ws + WS_KSEL), (const bf16*)(ws + WS_KWIN), (bf16*)(ws + WS_OATT), bg >> 2, bg & 3, qb, F.lds); }
                const float* csel = INF(3); const float* swin = INF(4); const int* pt = (const int*)tab_ptr(lds, 5);
#ifndef PROBE_DEC
#define PROBE_DEC 1
#endif
                for (int rp_ = 0; rp_ < PROBE_DEC; ++rp_)
                for (int un = blockIdx.x; un < NS * 4; un += F.G) dec::sample_attn_unit(csel, swin, pt, ws, F.out, un >> 2, un & 3, F.lds);
            }
            PH_END;
        }
        if (SITE_ON(7) && PH_ON) { MKFRAME;
            const bf16* A = (const bf16*)(ws + (layer < 2 ? WS_U : WS_OATT)); const bf16* W = (layer < 2) ? (const bf16*)(ws + WS_WAO) + (size_t)layer * 1024 * 1024 : (const bf16*)(ws + WS_WBO) + (size_t)(layer - 2) * 1024 * 1024;
            pg8::Gemm g{A, W, MP, DM, DM}; pg8::StaticOrder S; S.init(MP, DM, F.G, (int)blockIdx.x);
            EpiResid E{(bf16*)(ws + WS_XN), (float*)(ws + WS_ROWSS2)};
            pg8::gemm_phase<EpiResid, pg8::StaticOrder, true, true>(F.lds, g, S, E);
            SkResid SE{(float*)(ws + WS_HS)};
            skinny_gemm(F.lds, (const bf16*)(ws + (layer < 2 ? WS_USS : WS_OS)), W, DM, DM, SE);
        }
        PH_END;
        if (SITE_ON(9) && PH_ON) REP(9) { MKFRAME;
            const bf16* W = (const bf16*)(ws + WS_WUP) + (size_t)layer * 4096 * 1024;
            pg8::Gemm g{(const bf16*)(ws + WS_XN), W, MP, FF, DM}; pg8::StaticOrder S; S.init(MP, FF, F.G, (int)blockIdx.x);
            EpiSqRelu E{(bf16*)(ws + WS_H1), FF, (const float*)(ws + WS_ROWSS2)};
            pg8::gemm_phase<EpiSqRelu, pg8::StaticOrder, true, true>(F.lds, g, S, E);
            SkSqRelu SE{(bf16*)(ws + WS_H1S)};
            skinny_gemm_hs(F.lds, (const float*)(ws + WS_HS), W, FF, SE);
        }
        PH_END;
        if (SITE_ON(10) && PH_ON) { MKFRAME;
            const bf16* W = (const bf16*)(ws + WS_WDN) + (size_t)layer * 1024 * 4096;
            pg8::Gemm g{(const bf16*)(ws + WS_H1), W, MP, DM, FF}; pg8::StaticOrder S; S.init(MP, DM, F.G, (int)blockIdx.x);
            EpiResid E{(bf16*)(ws + WS_XN), (float*)(ws + WS_ROWSS2)};
            pg8::gemm_phase<EpiResid, pg8::StaticOrder, true, true>(F.lds, g, S, E);
            SkResid SE{(float*)(ws + WS_HS)};
            skinny_gemm(F.lds, (const bf16*)(ws + WS_H1S), W, FF, DM, SE);
        }
        PH_END;
        if (layer == 3) {
            if (SITE_ON(11) && PH_ON) { MKFRAME;
                float* HP = F.out + O_Y; const float* fg = INF(27); const float* HS = (const float*)(ws + WS_HS);
                for (int m = F.gw; m < MP + NS; m += F.NGW) {
                    if (m < MP) norm_row_bf16((const bf16*)(ws + WS_XN) + (size_t)m * DM, (const float*)(ws + WS_ROWSS2) + (size_t)m * 16, fg, HP + (size_t)m * DM, F.lane);
                    else norm_row_f32(HS + (size_t)(m - MP) * DM, fg, F.out + O_YS + (size_t)(m - MP) * DM, F.lane); }
            }
            PH_END;
        }
    }
#undef PH_ON
#undef PH_END
#undef MKFRAME
}
constexpr int N_PHASES = 1 + 2 * 5 + 6 + 5 + 1;

extern "C" void kernel_launch(void* const* d_in, const int* in_sizes, int n_in, void* d_out, int out_size, void* d_ws, size_t ws_size, hipStream_t stream) {
    static int grid = 0;
    if (grid == 0) {
        if (n_in != 28 || (size_t)out_size != O_END || ws_size < WS_END) { fprintf(stderr, "kernel_launch: unexpected shapes (n_in %d, out %d, ws %zu); nothing launched\n", n_in, out_size, ws_size); grid = -1; return; }
        int dev = 0, cus = 0, per_cu = 0;
        if (hipGetDevice(&dev) != hipSuccess || hipDeviceGetAttribute(&cus, hipDeviceAttributeMultiprocessorCount, dev) != hipSuccess) { grid = -1; return; }
        if (hipFuncSetAttribute((const void*)yoco_fwd, hipFuncAttributeMaxDynamicSharedMemorySize, LDS_BYTES) != hipSuccess) { fprintf(stderr, "kernel_launch: hipFuncSetAttribute failed\n"); grid = -1; return; }
        if (hipOccupancyMaxActiveBlocksPerMultiprocessor(&per_cu, (const void*)yoco_fwd, NWAVES * 64, LDS_BYTES) != hipSuccess || per_cu < 1) { fprintf(stderr, "kernel_launch: occupancy query reports %d blocks per CU\n", per_cu); }
        (void)hipGetLastError();
        grid = cus;
    }
    if (grid < 0) return;
    if (hipMemsetAsync((char*)d_ws + WS_CTL, 0, CTL_ZERO_BYTES, stream) != hipSuccess) return;
    Args a{};
    for (int i = 0; i < 28; ++i) a.in[i] = d_in[i];
    a.out = (float*)d_out; a.ws = (unsigned char*)d_ws; a.pad = 0;
#if MK_PER_PHASE
    for (int p = 0; p < N_PHASES; ++p) { a.ph_lo = p; a.ph_hi = p + 1; a.use_bar = 0; hipLaunchKernelGGL(yoco_fwd, dim3(grid), dim3(NWAVES * 64), LDS_BYTES, stream, a); }
#else
    a.ph_lo = 0; a.ph_hi = N_PHASES; a.use_bar = 1;
    hipLaunchKernelGGL(yoco_fwd, dim3(grid), dim3(NWAVES * 64), LDS_BYTES, stream, a);
#endif
    const hipError_t le = hipPeekAtLastError();
    if (le != hipSuccess) fprintf(stderr, "kernel_launch: launch failed: %s\n", hipGetErrorName(le));
}
```

```cpp
#include <hip/hip_runtime.h>
#include <cstdio>
#include <cstdint>
#ifndef MK_PER_PHASE
#define MK_PER_PHASE 0
#endif
namespace pg8 {
#define PG8_LAS __attribute__((address_space(3)))
typedef unsigned short bf16_t;
typedef short bf16x8 __attribute__((ext_vector_type(8)));
typedef float f32x4 __attribute__((ext_vector_type(4)));
typedef unsigned u32x4 __attribute__((ext_vector_type(4)));
constexpr int BM = 256, BK = 64, HALF = 128, HTB = HALF * BK * 2  , STAGE_BYTES = 8 * HTB, NXCD = 8, WGM = 8;

__host__ __device__ __forceinline__ int lds_byte(int r, int c) { const int st = (r >> 4) * 2 + (c >> 5), rr = r & 15, cc = c & 31, ob = rr * 64 + cc * 2; return st * 1024 + (ob ^ (((ob >> 9) & 1) << 5)); }
__host__ __device__ __forceinline__ void stage_rc(int b, int& R, int& C) { const int st = b / 1024, sb = b % 1024, swz = sb ^ (((sb >> 9) & 1) << 5); R = (st >> 1) * 16 + swz / 64; C = (st & 1) * 32 + (swz % 64) / 2; }
__host__ __device__ __forceinline__ int perm32(int rho) { const int n = rho >> 4, i = rho & 15; return 8 * (i >> 2) + 4 * n + (i & 3); }

struct Unit { int pm, pn; };
struct Gemm { const bf16_t* A; const bf16_t* Bt; int M, N, K; };

struct StaticOrder {
    int nM, nN, nwg, G, c;
    __host__ __device__ void init(int M, int N, int G_, int c_) { nM = M / BM; nN = N / BM; nwg = nM * nN; G = G_; c = c_; }
    __host__ __device__ bool next(int i, Unit& u) const {
        const long L = (long)i * G + c; if (L >= nwg) return false;
        int wgid = (int)L; { const int q = nwg / NXCD, r = nwg % NXCD, xcd = wgid % NXCD, off = wgid / NXCD; wgid = (xcd < r ? xcd * (q + 1) : r * (q + 1) + (xcd - r) * q) + off; }
        const int nig = WGM * nN, gid = wgid / nig, fm = gid * WGM, gsz = (nM - fm) < WGM ? (nM - fm) : WGM;
        u.pm = fm + ((wgid % nig) % gsz); u.pn = (wgid % nig) / gsz; return true;
    }
    __device__ __forceinline__ void a_ready(const Unit&) const {}
    __device__ __forceinline__ void done(const Unit&) const {}
};

}
namespace pg8 {
template <class Epi, class Sched, bool ALIGN_EPI = false, bool SP2 = false, int LDA = 0, int AJ = 0>
__device__ __forceinline__ void gemm_phase(PG8_LAS unsigned char* lds, const Gemm g, const Sched& S, const Epi& E) {
    int tid_l = threadIdx.x; asm volatile("" : "+v"(tid_l)); const int tid = tid_l, wid = __builtin_amdgcn_readfirstlane(tid >> 6), lane = tid & 63, wr = wid >> 2, wc = wid & 3, fr = lane & 15, fq = lane >> 4;
    const int K = g.K, nt = K / BK;
    unsigned voffA[2], voffB[2];
#pragma unroll
    for (int i = 0; i < 2; ++i) { int R, C; stage_rc(tid * 16 + i * 8192, R, C); const int Rb = Epi::PERM ? ((R & ~31) + perm32(R & 31)) : R;
        voffA[i] = (unsigned)(R * (LDA ? LDA : K) + C) * 2u; voffB[i] = (unsigned)(Rb * K + C) * 2u; }
    const size_t kstep = (size_t)(BK * 2);
    const size_t hstep = (size_t)HALF * K * 2;
    const size_t tstep = 2 * hstep;
    const size_t hstepA = LDA ? (size_t)HALF * LDA * 2 : hstep, tstepA = 2 * hstepA;
    const size_t ks1 = AJ ? (size_t)AJ : kstep, ks2 = AJ ? kstep : 2 * kstep;
    const unsigned ldsw = (unsigned)wid * 1024u;
    const int aoff = lds_byte(wr * 64 + fr, fq * 8), boff = lds_byte(wc * 32 + fr, fq * 8);
#define PG8_SA(b, h) (((b) * 2 + (h)) * HTB)
#define PG8_SB(b, h) ((4 + (b) * 2 + (h)) * HTB)
#define PG8_STAGE(bufoff, gbase, voff) do { _Pragma("unroll") for (int _i = 0; _i < 2; ++_i) \
        __builtin_amdgcn_global_load_lds((const unsigned*)((const char*)(gbase) + (voff)[_i]), (PG8_LAS unsigned*)(lds + (bufoff) + ldsw + _i * 8192), 16, 0, 0); } while (0)
#define PG8_LDA(dst, b, h) do { _Pragma("unroll") for (int m = 0; m < 4; ++m) _Pragma("unroll") for (int k = 0; k < 2; ++k) dst[m][k] = *(const PG8_LAS bf16x8*)(lds + PG8_SA(b, h) + aoff + m * 2048 + k * 1024); } while (0)
#define PG8_LDB(dst, b, h) do { _Pragma("unroll") for (int n = 0; n < 2; ++n) _Pragma("unroll") for (int k = 0; k < 2; ++k) dst[n][k] = *(const PG8_LAS bf16x8*)(lds + PG8_SB(b, h) + boff + n * 2048 + k * 1024); } while (0)
#define PG8_MMA(ai, bj, At, Bt) do { __builtin_amdgcn_s_setprio(1); _Pragma("unroll") for (int m = 0; m < 4; ++m) _Pragma("unroll") for (int n = 0; n < 2; ++n) _Pragma("unroll") for (int k = 0; k < 2; ++k) \
        acc[ai][bj][m][n] = __builtin_amdgcn_mfma_f32_16x16x32_bf16(Bt[n][k], At[m][k], acc[ai][bj][m][n], 0, 0, 0); __builtin_amdgcn_s_setprio(0); } while (0)
#define PG8_WAIT_V(n) asm volatile("s_waitcnt vmcnt(" #n ")" ::: "memory")
#define PG8_WAIT_L(n) asm volatile("s_waitcnt lgkmcnt(" #n ")" ::: "memory")
#define PG8_BAR __builtin_amdgcn_s_barrier()
#define PG8_SCHED __builtin_amdgcn_sched_barrier(0)
    Unit cur, nxt; int ui = 0;
    if (!S.next(0, cur)) return;
    f32x4 acc[2][2][4][2];
#pragma unroll
    for (int a = 0; a < 2; ++a)
#pragma unroll
        for (int b = 0; b < 2; ++b)
#pragma unroll
            for (int m = 0; m < 4; ++m)
#pragma unroll
                for (int n = 0; n < 2; ++n) acc[a][b][m][n] = (f32x4){0.f, 0.f, 0.f, 0.f};
    bf16x8 At[4][2], B0[2][2], B1[2][2];
    const char* cA = (const char*)g.A + (size_t)cur.pm * tstepA; const char* cB = (const char*)g.Bt + (size_t)cur.pn * tstep;
    S.a_ready(cur);
    if constexpr (SP2) {
        PG8_STAGE(PG8_SB(0, 0), cB, voffB); PG8_STAGE(PG8_SB(0, 1), cB + hstep, voffB); PG8_STAGE(PG8_SA(0, 0), cA, voffA); PG8_STAGE(PG8_SA(0, 1), cA + hstepA, voffA);
        if (wr == 1) PG8_BAR;
        PG8_WAIT_V(2); PG8_BAR;
        PG8_STAGE(PG8_SB(1, 0), cB + kstep, voffB); PG8_STAGE(PG8_SA(1, 0), cA + ks1, voffA); PG8_STAGE(PG8_SB(1, 1), cB + hstep + kstep, voffB);
        PG8_WAIT_V(6); PG8_BAR;
    } else {
        PG8_STAGE(PG8_SB(0, 0), cB, voffB); PG8_STAGE(PG8_SA(0, 0), cA, voffA); PG8_STAGE(PG8_SB(0, 1), cB + hstep, voffB); PG8_STAGE(PG8_SA(0, 1), cA + hstepA, voffA);
        if (wr == 1) PG8_BAR;
        PG8_WAIT_V(4); PG8_BAR;
        PG8_STAGE(PG8_SB(1, 0), cB + kstep, voffB); PG8_STAGE(PG8_SA(1, 0), cA + ks1, voffA); PG8_STAGE(PG8_SB(1, 1), cB + hstep + kstep, voffB);
        PG8_WAIT_V(6); PG8_BAR;
    }
    for (;;) {
        const bool has_next = S.next(ui + 1, nxt);
        const char* nA = has_next ? (const char*)g.A + (size_t)nxt.pm * tstepA : cA; const char* nB = has_next ? (const char*)g.Bt + (size_t)nxt.pn * tstep : cB;
        for (int t = 0; t < nt; t += 2) {
            const bool last = (t == nt - 2);
            const char* a1 = cA + (size_t)(t >> 1) * ks2 + ks1;
            const char* a2 = last ? nA : cA + (size_t)((t >> 1) + 1) * ks2; const char* b2 = last ? nB : cB + (size_t)(t + 2) * kstep;
            const char* a3 = a2 + ks1; const char* b3 = b2 + kstep;
            if (last && has_next) S.a_ready(nxt);
            if constexpr (SP2) {
            PG8_LDB(B0, 0, 0); PG8_LDB(B1, 0, 1); PG8_SCHED; PG8_LDA(At, 0, 0); PG8_STAGE(PG8_SA(1, 1), a1 + hstepA, voffA);
            PG8_WAIT_V(8); PG8_WAIT_L(0); PG8_BAR; PG8_MMA(0, 0, At, B0); PG8_MMA(0, 1, At, B1); PG8_BAR; PG8_SCHED;
            PG8_LDA(At, 0, 1); PG8_STAGE(PG8_SB(0, 0), b2, voffB); PG8_STAGE(PG8_SB(0, 1), b2 + hstep, voffB); PG8_STAGE(PG8_SA(0, 0), a2, voffA);
            PG8_WAIT_V(8); PG8_WAIT_L(0); PG8_BAR; PG8_MMA(1, 0, At, B0); PG8_MMA(1, 1, At, B1); PG8_BAR; PG8_SCHED;
            PG8_LDB(B0, 1, 0); PG8_LDB(B1, 1, 1); PG8_SCHED; PG8_LDA(At, 1, 0); PG8_STAGE(PG8_SA(0, 1), a2 + hstepA, voffA);
            PG8_WAIT_V(8); PG8_WAIT_L(0); PG8_BAR; PG8_MMA(0, 0, At, B0); PG8_MMA(0, 1, At, B1); PG8_BAR; PG8_SCHED;
            PG8_LDA(At, 1, 1); PG8_STAGE(PG8_SB(1, 0), b3, voffB); PG8_STAGE(PG8_SB(1, 1), b3 + hstep, voffB); PG8_STAGE(PG8_SA(1, 0), a3, voffA);
            PG8_WAIT_V(8); PG8_WAIT_L(0); PG8_BAR; PG8_MMA(1, 0, At, B0); PG8_MMA(1, 1, At, B1); PG8_BAR; PG8_SCHED;
            } else {
            PG8_LDB(B0, 0, 0); PG8_SCHED; PG8_LDA(At, 0, 0); PG8_STAGE(PG8_SA(1, 1), a1 + hstepA, voffA);
            PG8_WAIT_L(8); PG8_BAR; PG8_WAIT_L(0); PG8_MMA(0, 0, At, B0); PG8_BAR; PG8_SCHED;
            PG8_LDB(B1, 0, 1); PG8_STAGE(PG8_SB(0, 0), b2, voffB);
            PG8_BAR; PG8_WAIT_L(0); PG8_MMA(0, 1, At, B1); PG8_BAR;
            PG8_LDA(At, 0, 1); PG8_STAGE(PG8_SA(0, 0), a2, voffA);
            PG8_BAR; PG8_WAIT_L(0); PG8_MMA(1, 0, At, B0); PG8_BAR; PG8_SCHED;
            PG8_STAGE(PG8_SB(0, 1), b2 + hstep, voffB);
            PG8_WAIT_V(6); PG8_BAR; PG8_MMA(1, 1, At, B1); PG8_BAR;
            PG8_LDB(B0, 1, 0); PG8_SCHED; PG8_LDA(At, 1, 0); PG8_STAGE(PG8_SA(0, 1), a2 + hstepA, voffA);
            PG8_WAIT_L(8); PG8_BAR; PG8_WAIT_L(0); PG8_MMA(0, 0, At, B0); PG8_BAR; PG8_SCHED;
            PG8_LDB(B1, 1, 1); PG8_STAGE(PG8_SB(1, 0), b3, voffB);
            PG8_BAR; PG8_WAIT_L(0); PG8_MMA(0, 1, At, B1); PG8_BAR;
            PG8_LDA(At, 1, 1); PG8_STAGE(PG8_SA(1, 0), a3, voffA);
            PG8_BAR; PG8_WAIT_L(0); PG8_MMA(1, 0, At, B0); PG8_BAR; PG8_SCHED;
            PG8_STAGE(PG8_SB(1, 1), b3 + hstep, voffB);
            PG8_WAIT_V(6); PG8_BAR; PG8_MMA(1, 1, At, B1); PG8_BAR;
            }
        }
        if constexpr (ALIGN_EPI) { if (wr == 0) PG8_BAR; }
        if constexpr (!Epi::AFTER_DRAIN) { E(acc, cur, wr, wc, fr, fq); S.done(cur); }
        if (!has_next) break;
#pragma unroll
        for (int a = 0; a < 2; ++a)
#pragma unroll
            for (int b = 0; b < 2; ++b)
#pragma unroll
                for (int m = 0; m < 4; ++m)
#pragma unroll
                    for (int n = 0; n < 2; ++n) acc[a][b][m][n] = (f32x4){0.f, 0.f, 0.f, 0.f};
        cur = nxt; cA = nA; cB = nB; ++ui;
        if constexpr (ALIGN_EPI) { if (wr == 1) PG8_BAR; }
    }
    PG8_WAIT_V(0);
    if constexpr (!ALIGN_EPI) { if (wr == 0) PG8_BAR; }
    PG8_BAR;
    if constexpr (Epi::AFTER_DRAIN) { E.fused(acc, cur, wr, wc, fr, fq, lds, wid, lane); S.done(cur); }
#undef PG8_SA
#undef PG8_SB
#undef PG8_STAGE
#undef PG8_LDA
#undef PG8_LDB
#undef PG8_MMA
#undef PG8_WAIT_V
#undef PG8_WAIT_L
#undef PG8_BAR
#undef PG8_SCHED
}
}
#define LAS __attribute__((address_space(3)))
#define XB_TMO      128
#define XB_XCNT(j)  (256  + 64 * (j))
#define XB_XSUB(j)  (1280 + 64 * (j))
#define XB_XGEN(j)  (2304 + 64 * (j))
#define XB_TOP      3328
#define XB_TOPGEN   3392
#define XCD_BAR_WORDS 3456
#define XB_SPIN_CAP (1u << 18)

__device__ __forceinline__ unsigned xb_ld(unsigned* p)              { return __hip_atomic_load(p, __ATOMIC_RELAXED, __HIP_MEMORY_SCOPE_AGENT); }
__device__ __forceinline__ unsigned xb_add(unsigned* p, unsigned v) { return __hip_atomic_fetch_add(p, v, __ATOMIC_RELAXED, __HIP_MEMORY_SCOPE_AGENT); }
__device__ __forceinline__ unsigned xb_xcc_id() { return (unsigned)__builtin_amdgcn_s_getreg((3 << 11) | 20) & 0xFu; }
#define XB_SPIN(cond, bar) do { unsigned _sp = 0; while (cond) { __builtin_amdgcn_s_sleep(1); \
    if ((++_sp & 255u) == 0u) { if (xb_ld(&(bar)[XB_TMO])) break; if (_sp > XB_SPIN_CAP) { atomicAdd(&(bar)[XB_TMO], 1u); break; } } } } while (0)

struct XcdBarrier {
    unsigned* bar; unsigned x;
    volatile LAS unsigned* st;
};

__device__ __forceinline__ XcdBarrier xcd_barrier_post(unsigned* bar, volatile LAS unsigned* st) {
    XcdBarrier b; b.bar = bar; b.x = xb_xcc_id(); b.st = st;
    if (threadIdx.x == 0) (void)xb_add(&bar[XB_XCNT(b.x)], 1u);
    return b;
}
__device__ __forceinline__ void xcd_barrier_complete(unsigned* bar, unsigned x, unsigned& nloc, unsigned& nx) {
    const unsigned G = gridDim.x * gridDim.y * gridDim.z;
    unsigned sum, cnt, mine, sp = 0u;
    for (;;) {
        sum = 0u; cnt = 0u; mine = 0u;
#pragma unroll
        for (unsigned j = 0; j < 16; ++j) { const unsigned c = xb_ld(&bar[XB_XCNT(j)]); sum += c; cnt += (c > 0u) ? 1u : 0u; mine = (j == x) ? c : mine; }
        if (sum == G) break;
        __builtin_amdgcn_s_sleep(1);
        if ((++sp & 255u) == 0u) { if (xb_ld(&bar[XB_TMO])) break; if (sp > XB_SPIN_CAP) { atomicAdd(&bar[XB_TMO], 1u); break; } }
    }
    nloc = mine > 0u ? mine : 1u; nx = cnt > 0u ? cnt : 1u;
}

__device__ __forceinline__ void xcd_barrier(const XcdBarrier& b) {
    asm volatile("s_waitcnt vmcnt(0)" ::: "memory");
    __syncthreads();
    if (threadIdx.x == 0) {
        unsigned* bar = b.bar;
        __builtin_amdgcn_s_waitcnt(0);
        unsigned nloc = b.st[0], nx = b.st[1];
        if (nloc == 0u) { xcd_barrier_complete(bar, b.x, nloc, nx); b.st[0] = nloc; b.st[1] = nx; }
        const unsigned old = xb_add(&bar[XB_XSUB(b.x)], 1u);
        const unsigned gen = old / nloc;
        if (old + 1u == (gen + 1u) * nloc) {
            __builtin_amdgcn_fence(__ATOMIC_RELEASE, "agent");
            asm volatile("s_waitcnt vmcnt(0)" ::: "memory");
            const unsigned og = xb_add(&bar[XB_TOP], 1u);
            const unsigned tg = og / nx;
            if (og + 1u == (tg + 1u) * nx) xb_add(&bar[XB_TOPGEN], 1u);
            else XB_SPIN(xb_ld(&bar[XB_TOPGEN]) == tg, bar);
            __builtin_amdgcn_fence(__ATOMIC_ACQUIRE, "agent");
            xb_add(&bar[XB_XGEN(b.x)], 1u);
            asm volatile("s_waitcnt vmcnt(0)" ::: "memory");
        } else {
            XB_SPIN(xb_ld(&bar[XB_XGEN(b.x)]) == gen, bar);
            __builtin_amdgcn_fence(__ATOMIC_ACQUIRE, "agent");
            asm volatile("s_waitcnt vmcnt(0)" ::: "memory");
        }
    }
    __syncthreads();
}

#define GAS __attribute__((address_space(1)))
typedef unsigned short bf16;
typedef unsigned v4u __attribute__((ext_vector_type(4)));
typedef unsigned v2u __attribute__((ext_vector_type(2)));
typedef float f32x4 __attribute__((ext_vector_type(4)));
typedef float f32x2 __attribute__((ext_vector_type(2)));
typedef float f32x16 __attribute__((ext_vector_type(16)));
typedef short bf16x8 __attribute__((ext_vector_type(8)));
typedef short s16x4 __attribute__((ext_vector_type(4)));
typedef __bf16 bf16x2_t __attribute__((ext_vector_type(2)));
#define LDS_WAIT() asm volatile("s_waitcnt lgkmcnt(0)" ::: "memory")
#define VM_WAIT() asm volatile("s_waitcnt vmcnt(0)" ::: "memory")

__device__ __forceinline__ unsigned pk2(float lo, float hi) { f32x2 v = {lo, hi}; bf16x2_t b = __builtin_convertvector(v, bf16x2_t); return __builtin_bit_cast(unsigned, b); }
__device__ __forceinline__ float bf_lo(unsigned u) { return __uint_as_float(u << 16); }
__device__ __forceinline__ float bf_hi(unsigned u) { return __uint_as_float(u & 0xffff0000u); }
__device__ __forceinline__ float bf1(bf16 h) { return __uint_as_float(((unsigned)h) << 16); }
__device__ __forceinline__ float wave_sum(float v) {
#pragma unroll
    for (int o = 1; o < 64; o <<= 1) v += __shfl_xor(v, o);
    return v;
}
__device__ __forceinline__ float wave_max(float v) {
#pragma unroll
    for (int o = 1; o < 64; o <<= 1) v = fmaxf(v, __shfl_xor(v, o));
    return v;
}
__device__ __forceinline__ float swap_max(float m) { auto rr = __builtin_amdgcn_permlane32_swap(__float_as_uint(m), __float_as_uint(m), false, false); return fmaxf(__uint_as_float(rr[0]), __uint_as_float(rr[1])); }
__device__ __forceinline__ float swap_sum(float m) { auto rr = __builtin_amdgcn_permlane32_swap(__float_as_uint(m), __float_as_uint(m), false, false); return __uint_as_float(rr[0]) + __uint_as_float(rr[1]); }
__device__ __forceinline__ float fast_exp2(float x) { return __builtin_amdgcn_exp2f(x); }
__device__ __forceinline__ float quad_sum(float x) {
    float y = x + __int_as_float(__builtin_amdgcn_update_dpp(0, __float_as_int(x), 0xB1, 0xF, 0xF, true));
    return y + __int_as_float(__builtin_amdgcn_update_dpp(0, __float_as_int(y), 0x4E, 0xF, 0xF, true));
}
__device__ __forceinline__ float row16_sum(float x) {
    float y = quad_sum(x);
    y += __int_as_float(__builtin_amdgcn_update_dpp(0, __float_as_int(y), 0x124, 0xF, 0xF, true));
    return y + __int_as_float(__builtin_amdgcn_update_dpp(0, __float_as_int(y), 0x128, 0xF, 0xF, true));
}

constexpr int DM = 1024, SEQ = 8192, MP = 2 * SEQ, NS = 32, FF = 4096;
constexpr float EPS = 1e-6f;
constexpr float C2 = 0.125f * 1.4426950408889634f;
constexpr int NKVQG = 2816, NQG1 = 1280;
constexpr int ACMP_ROWS = 69632;
constexpr size_t O_Y = 0, O_YS = 16777216, O_CMP = 16809984, O_SEL = 25198592, O_WIN = 33587200, O_CMPS = 34111488, O_SELS = 34127872, O_WINS = 34144256, O_AV = 42532864, O_END = 42598400;

constexpr size_t MiB = 1u << 20;
constexpr size_t WS_CTL = 0, CTL_ZERO_BYTES = 1 * MiB;
constexpr size_t WS_WUV = 2 * MiB, WS_WAO = 10 * MiB, WS_WSB = 14 * MiB, WS_WKVQG = 15 * MiB, WS_WQG1 = 21 * MiB, WS_WBO = 24 * MiB, WS_WUP = 28 * MiB, WS_WDN = 60 * MiB, WS_WC1 = 92 * MiB, WS_WC2 = 94 * MiB;
constexpr size_t WS_BIAS1 = 94 * MiB + 512 * 1024;
constexpr size_t WS_ROWSS2 = 194 * MiB;
constexpr size_t WS_XN = 96 * MiB, WS_U = 128 * MiB, WS_V = 160 * MiB, WS_ROWSS = 192 * MiB, WS_H1 = 200 * MiB, WS_KSEL = 328 * MiB, WS_KWIN = 344 * MiB, WS_Q = 360 * MiB, WS_GATES = 392 * MiB, WS_OATT = 396 * MiB;
constexpr size_t WS_ACMP = 428 * MiB, WS_TB = 700 * MiB, WS_TB_STRIDE = 70 * MiB, WS_KC = 840 * MiB, WS_VC = 850 * MiB;
constexpr size_t WS_SMP = 860 * MiB, SMP_SLOT = 256 * 1024;
constexpr size_t WS_XNS = WS_SMP, WS_USU = WS_SMP + 1 * SMP_SLOT, WS_VSF = WS_SMP + 2 * SMP_SLOT, WS_USS = WS_SMP + 3 * SMP_SLOT, WS_H1S = WS_SMP + 4 * SMP_SLOT, WS_QS = WS_SMP + 5 * SMP_SLOT, WS_GS = WS_SMP + 6 * SMP_SLOT, WS_OS = WS_SMP + 7 * SMP_SLOT, WS_HS = WS_SMP + 8 * SMP_SLOT;
constexpr size_t WS_HB = 864 * MiB;
constexpr size_t WS_WC1F = 932 * MiB;
constexpr size_t WS_END = 936 * MiB;
constexpr int CW_BAR = 4096;

constexpr int RING_BYTES = 131072, LDS_BYTES = 147456, LDSCTL_OFF = LDS_BYTES - 2048, MISC_OFF = LDSCTL_OFF + 320;
constexpr int NWAVES = 8;

struct Args { const void* in[28]; float* out; unsigned char* ws; int ph_lo, ph_hi, use_bar, pad; };

__device__ __forceinline__ void rows_rstd(const float* rs, int row0, int fq, float (&r)[2][4]) {
    pg8::f32x4 p[2][4];
#pragma unroll
    for (int ai = 0; ai < 2; ++ai)
#pragma unroll
        for (int m = 0; m < 4; ++m) p[ai][m] = *(const pg8::f32x4*)(rs + (size_t)(row0 + ai * 128 + m * 16) * 16 + 4 * fq);
#pragma unroll
    for (int ai = 0; ai < 2; ++ai)
#pragma unroll
        for (int m = 0; m < 4; ++m) { float t = (p[ai][m][0] + p[ai][m][1]) + (p[ai][m][2] + p[ai][m][3]); t += __shfl_xor(t, 16); t += __shfl_xor(t, 32); r[ai][m] = rsqrtf(t * (1.f / DM) + EPS); }
}
constexpr int RSTD_CACHE_OFF = RING_BYTES + 4096;
__device__ __forceinline__ void rows_rstd_cached(const float* rs, int pm, int& last_pm, int row0, int wr, int wc, int fr, int fq, float (&r)[2][4]) {
    extern __shared__ __attribute__((aligned(16))) unsigned char lds_dyn_base[];
    LAS float* rc = (LAS float*)((LAS unsigned char*)lds_dyn_base + RSTD_CACHE_OFF) + wr * 64 + fr;
    if (pm != last_pm) { rows_rstd(rs, row0, fq, r); last_pm = pm;
        if (wc == 0 && fq == 0) {
#pragma unroll
            for (int ai = 0; ai < 2; ++ai)
#pragma unroll
                for (int m = 0; m < 4; ++m) rc[ai * 128 + m * 16] = r[ai][m]; } }
    else {
#pragma unroll
        for (int ai = 0; ai < 2; ++ai)
#pragma unroll
            for (int m = 0; m < 4; ++m) r[ai][m] = rc[ai * 128 + m * 16]; }
}
struct EpiUV {
    static constexpr bool PERM = true, AFTER_DRAIN = false;
    bf16* U; bf16* V; float* rowss; const float* rs_in; mutable int last_pm = -1;
    __device__ __forceinline__ void operator()(const pg8::f32x4 (&acc)[2][2][4][2], const pg8::Unit& u, int wr, int wc, int fr_, int fq_) const {
        int fr = fr_, fq = fq_; asm volatile("" : "+v"(fr), "+v"(fq));
        const bool isv = u.pn >= 4; bf16* base = isv ? V : U;
        const int row0 = u.pm * 256 + wr * 64 + fr, col0 = (u.pn & 3) * 256 + wc * 32 + 8 * fq;
        float rs8[2][4]; rows_rstd_cached(rs_in, u.pm, last_pm, row0, wr, wc, fr, fq, rs8);
#pragma unroll
        for (int ai = 0; ai < 2; ++ai)
#pragma unroll
            for (int m = 0; m < 4; ++m) { const int row = row0 + ai * 128 + m * 16; float ss = 0.f; const float rstd = rs8[ai][m];
#pragma unroll
                for (int bj = 0; bj < 2; ++bj) { const pg8::f32x4 v0 = acc[ai][bj][m][0] * rstd, v1 = acc[ai][bj][m][1] * rstd;
                    ss += (v0[0] * v0[0] + v0[1] * v0[1]) + (v0[2] * v0[2] + v0[3] * v0[3]) + (v1[0] * v1[0] + v1[1] * v1[1]) + (v1[2] * v1[2] + v1[3] * v1[3]);
                    v4u w; w.x = pk2(v0[0], v0[1]); w.y = pk2(v0[2], v0[3]); w.z = pk2(v1[0], v1[1]); w.w = pk2(v1[2], v1[3]);
                    *(v4u*)(base + (size_t)row * DM + col0 + bj * 128) = w; }
                if (isv) { ss += __shfl_xor(ss, 16); ss += __shfl_xor(ss, 32); if (fq == 0) rowss[(size_t)row * 16 + (u.pn - 4) * 4 + wc] = ss; } }
    }
};
struct EpiSqRelu {
    static constexpr bool PERM = true, AFTER_DRAIN = false;
    bf16* O; int ldc; const float* rs_in; mutable int last_pm = -1;
    __device__ __forceinline__ void operator()(const pg8::f32x4 (&acc)[2][2][4][2], const pg8::Unit& u, int wr, int wc, int fr_, int fq_) const {
        int fr = fr_, fq = fq_; asm volatile("" : "+v"(fr), "+v"(fq));
        const int row0 = u.pm * 256 + wr * 64 + fr, col0 = u.pn * 256 + wc * 32 + 8 * fq;
        float rs8[2][4]; rows_rstd_cached(rs_in, u.pm, last_pm, row0, wr, wc, fr, fq, rs8);
#pragma unroll
        for (int ai = 0; ai < 2; ++ai)
#pragma unroll
            for (int m = 0; m < 4; ++m) { const int row = row0 + ai * 128 + m * 16; const float rstd = rs8[ai][m];
#pragma unroll
                for (int bj = 0; bj < 2; ++bj) { pg8::f32x4 v0 = acc[ai][bj][m][0], v1 = acc[ai][bj][m][1];
#pragma unroll
                    for (int e = 0; e < 4; ++e) { const float a = fmaxf(v0[e] * rstd, 0.f), b = fmaxf(v1[e] * rstd, 0.f); v0[e] = a * a; v1[e] = b * b; }
                    v4u w; w.x = pk2(v0[0], v0[1]); w.y = pk2(v0[2], v0[3]); w.z = pk2(v1[0], v1[1]); w.w = pk2(v1[2], v1[3]);
                    *(v4u*)(O + (size_t)row * ldc + col0 + bj * 128) = w; } }
    }
};
struct EpiStore {
    static constexpr bool PERM = true, AFTER_DRAIN = false;
    bf16* O; int ldc;
    __device__ __forceinline__ void operator()(const pg8::f32x4 (&acc)[2][2][4][2], const pg8::Unit& u, int wr, int wc, int fr_, int fq_) const {
        int fr = fr_, fq = fq_; asm volatile("" : "+v"(fr), "+v"(fq));
        const int row0 = u.pm * 256 + wr * 64 + fr, col0 = u.pn * 256 + wc * 32 + 8 * fq;
#pragma unroll
        for (int ai = 0; ai < 2; ++ai)
#pragma unroll
            for (int m = 0; m < 4; ++m) { const int row = row0 + ai * 128 + m * 16;
#pragma unroll
                for (int bj = 0; bj < 2; ++bj) { const pg8::f32x4 v0 = acc[ai][bj][m][0], v1 = acc[ai][bj][m][1];
                    v4u w; w.x = pk2(v0[0], v0[1]); w.y = pk2(v0[2], v0[3]); w.z = pk2(v1[0], v1[1]); w.w = pk2(v1[2], v1[3]);
                    *(v4u*)(O + (size_t)row * ldc + col0 + bj * 128) = w; } }
    }
};
struct TBOrder {
    int G, c;
    __device__ __forceinline__ bool next(int i, pg8::Unit& u) const {
        if (G != 256) { const int L = i * G + c; if (L >= 1088) return false; const int kv = L >= 544 ? 1 : 0, r = L - 544 * kv; u.pm = 272 * kv + (r >> 1); u.pn = 2 * kv + (r & 1); return true; }
        const int x = c & 7, y = c >> 3, pmidx = i * 128 + (y >> 1) * 8 + x; if (pmidx >= 544) return false;
        const int kv = pmidx >= 272 ? 1 : 0; u.pm = pmidx; u.pn = 2 * kv + (y & 1); return true; }
    __device__ __forceinline__ void a_ready(const pg8::Unit&) const {}
    __device__ __forceinline__ void done(const pg8::Unit&) const {}
};
__device__ __forceinline__ float gelu_tanh(float x) { const float y = 0.7978845608028654f * (x + 0.044715f * x * x * x); return x / (1.f + __expf(-2.f * y)); }
__device__ __forceinline__ void combine16_fused(const bf16* __restrict__ HBk, const bf16* __restrict__ w2t, bf16* __restrict__ outp, int un, int lane) {
    const int m = un * 16 + (lane & 15), ko = 8 * (lane >> 4); const bool dead = ((m >> 2) & 511) == 511;
    f32x4 acc[4];
#pragma unroll
    for (int nt = 0; nt < 4; ++nt) acc[nt] = (f32x4){0.f, 0.f, 0.f, 0.f};
    v4u hva[8];
#pragma unroll
    for (int ks = 0; ks < 8; ++ks) hva[ks] = *(const v4u*)(HBk + (size_t)m * 256 + 32 * ks + ko);
#pragma unroll
    for (int ks = 0; ks < 8; ++ks) { const int k = 32 * ks + ko; const bf16x8 hf = __builtin_bit_cast(bf16x8, hva[ks]);
#pragma unroll
        for (int nt = 0; nt < 4; ++nt) { const bf16x8 wf = *(const bf16x8*)(w2t + (size_t)(16 * nt + (lane & 15)) * 256 + k);
            acc[nt] = __builtin_amdgcn_mfma_f32_16x16x32_bf16(wf, hf, acc[nt], 0, 0, 0); } }
#pragma unroll
    for (int nt = 0; nt < 4; ++nt) { v2u o; o.x = dead ? 0u : pk2(acc[nt][0], acc[nt][1]); o.y = dead ? 0u : pk2(acc[nt][2], acc[nt][3]);
        *(v2u*)(outp + (size_t)m * 64 + 16 * nt + 4 * (lane >> 4)) = o; }
}
__device__ __forceinline__ void combine16_tb(const bf16* __restrict__ TB, const float* __restrict__ bias1, const bf16* __restrict__ w2t, bf16* __restrict__ outp, int un, int lane) {
    const int m = un * 16 + (lane & 15), ko = 8 * (lane >> 4); const bool dead = ((m >> 2) & 511) == 511;
    f32x4 acc[4];
#pragma unroll
    for (int nt = 0; nt < 4; ++nt) acc[nt] = (f32x4){0.f, 0.f, 0.f, 0.f};
    v4u tva[8], bva[8];
#pragma unroll
    for (int ks = 0; ks < 8; ++ks) { const int k = 32 * ks + ko; tva[ks] = (v4u){0u, 0u, 0u, 0u}; bva[ks] = (v4u){0u, 0u, 0u, 0u};
        if (!dead) { tva[ks] = *(const v4u*)(TB + (size_t)m * 512 + k); bva[ks] = *(const v4u*)(TB + (size_t)(m + 4) * 512 + 256 + k); } }
#pragma unroll
    for (int ks = 0; ks < 8; ++ks) { const int k = 32 * ks + ko; const v4u tv = tva[ks], bv = bva[ks];
        const f32x4 b0 = *(const f32x4*)(bias1 + k), b1 = *(const f32x4*)(bias1 + k + 4);
        v4u hp;
        hp.x = pk2(gelu_tanh(bf_lo(tv.x) + bf_lo(bv.x) + b0.x), gelu_tanh(bf_hi(tv.x) + bf_hi(bv.x) + b0.y));
        hp.y = pk2(gelu_tanh(bf_lo(tv.y) + bf_lo(bv.y) + b0.z), gelu_tanh(bf_hi(tv.y) + bf_hi(bv.y) + b0.w));
        hp.z = pk2(gelu_tanh(bf_lo(tv.z) + bf_lo(bv.z) + b1.x), gelu_tanh(bf_hi(tv.z) + bf_hi(bv.z) + b1.y));
        hp.w = pk2(gelu_tanh(bf_lo(tv.w) + bf_lo(bv.w) + b1.z), gelu_tanh(bf_hi(tv.w) + bf_hi(bv.w) + b1.w));
        const bf16x8 hf = __builtin_bit_cast(bf16x8, hp);
#pragma unroll
        for (int nt = 0; nt < 4; ++nt) { const bf16x8 wf = *(const bf16x8*)(w2t + (size_t)(16 * nt + (lane & 15)) * 256 + k);
            acc[nt] = __builtin_amdgcn_mfma_f32_16x16x32_bf16(wf, hf, acc[nt], 0, 0, 0); } }
#pragma unroll
    for (int nt = 0; nt < 4; ++nt) { v2u o; o.x = dead ? 0u : pk2(acc[nt][0], acc[nt][1]); o.y = dead ? 0u : pk2(acc[nt][2], acc[nt][3]);
        *(v2u*)(outp + (size_t)m * 64 + 16 * nt + 4 * (lane >> 4)) = o; }
}
struct TBFOrder {
    int G, c; const bf16* HB; const bf16* W2; bf16* KC; bf16* VC;
    __device__ __forceinline__ bool next(int i, pg8::Unit& u) const { const int L = i * G + c; if (L >= 512) return false; const int kv = L >> 8, idx = L & 255, rt = idx < 240 ? idx : idx + 16; u.pm = 272 * kv + rt; u.pn = kv; return true; }
    __device__ __forceinline__ void a_ready(const pg8::Unit&) const {}
    __device__ __forceinline__ void done(const pg8::Unit& u) const {
        asm volatile("s_waitcnt vmcnt(0)" ::: "memory");
        __syncthreads();
        int tid_l = threadIdx.x; asm volatile("" : "+v"(tid_l)); const int lane = tid_l & 63, w = __builtin_amdgcn_readfirstlane(tid_l >> 6);
        const int kv = u.pn, un0 = (u.pm - 272 * kv) * 16 + 2 * w;
        const bf16* HBk = HB + (size_t)kv * ACMP_ROWS * 256; const bf16* w2t = W2 + (size_t)kv * 64 * 256; bf16* outp = kv ? VC : KC;
        combine16_fused(HBk, w2t, outp, un0, lane); combine16_fused(HBk, w2t, outp, un0 + 1, lane);
    }
};
struct TBEarlyOrder {
    int G, c;
    __device__ __forceinline__ bool next(int i, pg8::Unit& u) const { int e;
        if (G == 256) { if (i != 0 || c < 192) return false; e = c - 192; } else { e = i * G + c; if (e >= 64) return false; }
        const int x = e & 7, y = e >> 3, pidx = (y >> 1) * 8 + x, kv = pidx >> 4; u.pm = 272 * kv + 240 + (pidx & 15); u.pn = 2 * kv + (y & 1); return true; }
    __device__ __forceinline__ void a_ready(const pg8::Unit&) const {}
    __device__ __forceinline__ void done(const pg8::Unit&) const {}
};
struct EpiH {
    static constexpr bool PERM = true, AFTER_DRAIN = false;
    bf16* HB; const float* bias1;
    __device__ __forceinline__ void operator()(const pg8::f32x4 (&acc)[2][2][4][2], const pg8::Unit& u, int wr, int wc, int fr_, int fq_) const {
        int fr = fr_, fq = fq_; asm volatile("" : "+v"(fr), "+v"(fq));
        const int row0 = u.pm * 256 + wr * 64 + fr, col0 = wc * 32 + 8 * fq; const float* bp = bias1 + u.pn * 256 + col0;
#pragma unroll
        for (int bj = 0; bj < 2; ++bj) { const pg8::f32x4 b0 = *(const pg8::f32x4*)(bp + bj * 128), b1 = *(const pg8::f32x4*)(bp + bj * 128 + 4);
#pragma unroll
            for (int ai = 0; ai < 2; ++ai)
#pragma unroll
                for (int m = 0; m < 4; ++m) { const int row = row0 + ai * 128 + m * 16; const pg8::f32x4 v0 = acc[ai][bj][m][0] + b0, v1 = acc[ai][bj][m][1] + b1;
                    v4u w; w.x = pk2(gelu_tanh(v0[0]), gelu_tanh(v0[1])); w.y = pk2(gelu_tanh(v0[2]), gelu_tanh(v0[3])); w.z = pk2(gelu_tanh(v1[0]), gelu_tanh(v1[1])); w.w = pk2(gelu_tanh(v1[2]), gelu_tanh(v1[3]));
                    *(v4u*)(HB + (size_t)row * 256 + col0 + bj * 128) = w; } }
    }
};
struct EpiTB {
    static constexpr bool PERM = true, AFTER_DRAIN = false;
    bf16* TB;
    __device__ __forceinline__ void operator()(const pg8::f32x4 (&acc)[2][2][4][2], const pg8::Unit& u, int wr, int wc, int fr_, int fq_) const {
        int fr = fr_, fq = fq_; asm volatile("" : "+v"(fr), "+v"(fq));
        const int kv = u.pn >> 1; bf16* O = TB + (size_t)kv * (WS_TB_STRIDE / 2);
        const int row0 = (u.pm - 272 * kv) * 256 + wr * 64 + fr, col0 = (u.pn & 1) * 256 + wc * 32 + 8 * fq;
#pragma unroll
        for (int ai = 0; ai < 2; ++ai)
#pragma unroll
            for (int m = 0; m < 4; ++m) { const int row = row0 + ai * 128 + m * 16;
#pragma unroll
                for (int bj = 0; bj < 2; ++bj) { const pg8::f32x4 v0 = acc[ai][bj][m][0], v1 = acc[ai][bj][m][1];
                    v4u w; w.x = pk2(v0[0], v0[1]); w.y = pk2(v0[2], v0[3]); w.z = pk2(v1[0], v1[1]); w.w = pk2(v1[2], v1[3]);
                    *(v4u*)(O + (size_t)row * 512 + col0 + bj * 128) = w; } }
    }
};
struct EpiResid {
    static constexpr bool PERM = true, AFTER_DRAIN = false;
    bf16* xb; float* rs_out;
    __device__ __forceinline__ void operator()(const pg8::f32x4 (&acc)[2][2][4][2], const pg8::Unit& u, int wr, int wc, int fr_, int fq_) const {
        int fr = fr_, fq = fq_; asm volatile("" : "+v"(fr), "+v"(fq));
        const int row0 = u.pm * 256 + wr * 64 + fr, col0 = u.pn * 256 + wc * 32 + 8 * fq;
#pragma unroll
        for (int ai = 0; ai < 2; ++ai) {
            v4u bx[4][2];
#pragma unroll
            for (int m = 0; m < 4; ++m)
#pragma unroll
                for (int bj = 0; bj < 2; ++bj) bx[m][bj] = *(const v4u*)(xb + (size_t)(row0 + ai * 128 + m * 16) * DM + col0 + bj * 128);
            asm volatile("" ::: "memory");
#pragma unroll
            for (int m = 0; m < 4; ++m) { const int row = row0 + ai * 128 + m * 16; float ss = 0.f;
#pragma unroll
                for (int bj = 0; bj < 2; ++bj) { const v4u b = bx[m][bj]; const pg8::f32x4 a0 = acc[ai][bj][m][0], a1 = acc[ai][bj][m][1];
                    const float x0 = bf_lo(b.x) + a0[0], x1 = bf_hi(b.x) + a0[1], x2 = bf_lo(b.y) + a0[2], x3 = bf_hi(b.y) + a0[3];
                    const float x4 = bf_lo(b.z) + a1[0], x5 = bf_hi(b.z) + a1[1], x6 = bf_lo(b.w) + a1[2], x7 = bf_hi(b.w) + a1[3];
                    ss += ((x0 * x0 + x1 * x1) + (x2 * x2 + x3 * x3)) + ((x4 * x4 + x5 * x5) + (x6 * x6 + x7 * x7));
                    v4u w; w.x = pk2(x0, x1); w.y = pk2(x2, x3); w.z = pk2(x4, x5); w.w = pk2(x6, x7);
                    *(v4u*)(xb + (size_t)row * DM + col0 + bj * 128) = w; }
                ss += __shfl_xor(ss, 16); ss += __shfl_xor(ss, 32); if (fq == 0) rs_out[(size_t)row * 16 + u.pn * 4 + wc] = ss; }
            asm volatile("" ::: "memory");
        }
    }
};
struct EpiKVQG {
    static constexpr bool PERM = false, AFTER_DRAIN = false;
    float* out; bf16* acmp; bf16* ksel; bf16* kwin; bf16* q; float* gates; const float* bg; int tile_off; const float* rs_in; mutable int last_pm = -1;
    __device__ __forceinline__ void operator()(const pg8::f32x4 (&acc)[2][2][4][2], const pg8::Unit& u, int wr, int wc, int fr_, int fq_) const {
        int fr = fr_, fq = fq_; asm volatile("" : "+v"(fr), "+v"(fq));
        const int kind = u.pn + tile_off;
        const int row0 = u.pm * 256 + wr * 64 + fr, cw = wc * 32 + 4 * fq;
        float rs8[2][4]; rows_rstd_cached(rs_in, u.pm, last_pm, row0, wr, wc, fr, fq, rs8);
#pragma unroll
        for (int ai = 0; ai < 2; ++ai)
#pragma unroll
            for (int m = 0; m < 4; ++m) { const int row = row0 + ai * 128 + m * 16, b = row >> 13, t = row & 8191; const float rstd = rs8[ai][m];
#pragma unroll
                for (int bj = 0; bj < 2; ++bj)
#pragma unroll
                    for (int n = 0; n < 2; ++n) { const int ct = cw + bj * 128 + n * 16; const pg8::f32x4 v = acc[ai][bj][m][n] * rstd;
                        if (kind < 2) {
                            *(pg8::f32x4*)(out + O_CMP + (size_t)row * 512 + kind * 256 + ct) = v;
                            bf16* dst = acmp + ((size_t)kind * ACMP_ROWS + 65536 + (size_t)((b * 512 + (t >> 4)) * 4 + (ct >> 6))) * 1024 + (t & 15) * 64 + (ct & 63);
                            v2u w; w.x = pk2(v[0], v[1]); w.y = pk2(v[2], v[3]); *(v2u*)dst = w;
                        } else if (kind < 4) {
                            *(pg8::f32x4*)(out + O_SEL + (size_t)row * 512 + (kind - 2) * 256 + ct) = v;
                            v2u w; w.x = pk2(v[0], v[1]); w.y = pk2(v[2], v[3]); *(v2u*)(ksel + (size_t)row * 512 + (kind - 2) * 256 + ct) = w;
                        } else if (kind < 6) {
                            if (t >= SEQ - 512) *(pg8::f32x4*)(out + O_WIN + (size_t)(b * 512 + t - (SEQ - 512)) * 512 + (kind - 4) * 256 + ct) = v;
                            v2u w; w.x = pk2(v[0], v[1]); w.y = pk2(v[2], v[3]); *(v2u*)(kwin + (size_t)row * 512 + (kind - 4) * 256 + ct) = w;
                        } else if (kind < 10) {
                            v2u w; w.x = pk2(v[0] * C2, v[1] * C2); w.y = pk2(v[2] * C2, v[3] * C2); *(v2u*)(q + (size_t)row * DM + (kind - 6) * 256 + ct) = w;
                        } else {
                            if (ct < 48) { pg8::f32x4 o;
#pragma unroll
                                for (int e = 0; e < 4; ++e) o[e] = 1.f / (1.f + __expf(-(v[e] + bg[ct + e])));
                                *(pg8::f32x4*)(gates + (size_t)row * 48 + ct) = o; }
                        } } }
    }
};

template <int NT, class Epi>
__device__ __forceinline__ void wave_gemm16(const bf16* __restrict__ A, const bf16* __restrict__ W, int M, int N, int gw, int NGW, int lane, const Epi& E) {
    const int ncg = N / (16 * NT), nun = (M >> 4) * ncg;
    for (int un = gw; un < nun; un += NGW) { const int rt = un / ncg, cg = un - rt * ncg;
        f32x4 acc[NT];
#pragma unroll
        for (int nt = 0; nt < NT; ++nt) acc[nt] = (f32x4){0.f, 0.f, 0.f, 0.f};
        const bf16* ap = A + (size_t)(rt * 16 + (lane & 15)) * 1024 + 8 * (lane >> 4);
        const bf16* wp = W + (size_t)(cg * NT * 16 + (lane & 15)) * 1024 + 8 * (lane >> 4);
#pragma unroll 4
        for (int k = 0; k < 1024; k += 32) { const bf16x8 a = *(const bf16x8*)(ap + k);
#pragma unroll
            for (int nt = 0; nt < NT; ++nt) { const bf16x8 w = *(const bf16x8*)(wp + (size_t)nt * 16 * 1024 + k); acc[nt] = __builtin_amdgcn_mfma_f32_16x16x32_bf16(w, a, acc[nt], 0, 0, 0); } }
#pragma unroll
        for (int nt = 0; nt < NT; ++nt) E(rt * 16 + (lane & 15), (cg * NT + nt) * 16 + 4 * (lane >> 4), acc[nt]);
    }
}
struct WgStoreBf16 { bf16* O; int ldc; __device__ __forceinline__ void operator()(int row, int col0, const f32x4& v) const { v2u w; w.x = pk2(v[0], v[1]); w.y = pk2(v[2], v[3]); *(v2u*)(O + (size_t)row * ldc + col0) = w; } };
struct WgGates { float* gates; const float* bg; const float* rs;
    __device__ __forceinline__ void operator()(int row, int col0, const f32x4& v) const {
        const f32x4* p = (const f32x4*)(rs + (size_t)row * 16); const f32x4 a = p[0], b = p[1], c = p[2], d = p[3];
        const float t = ((a[0] + a[1]) + (a[2] + a[3])) + ((b[0] + b[1]) + (b[2] + b[3])) + ((c[0] + c[1]) + (c[2] + c[3])) + ((d[0] + d[1]) + (d[2] + d[3]));
        const float rstd = rsqrtf(t * (1.f / DM) + EPS); f32x4 o;
#pragma unroll
        for (int e = 0; e < 4; ++e) o[e] = 1.f / (1.f + __expf(-(v[e] * rstd + bg[col0 + e])));
        *(f32x4*)(gates + (size_t)row * 48 + col0) = o; } };

template <class Epi>
__device__ __forceinline__ void skinny_gemm(LAS unsigned char* lds, const bf16* __restrict__ A, const bf16* __restrict__ Wt, int K, int N, const Epi& E) {
    int tid_l = threadIdx.x; asm volatile("" : "+v"(tid_l)); const int tid = tid_l, lane = tid & 63, wid = tid >> 6;
    LAS float* red = (LAS float*)lds;
    const int kper = K >> 3, kbeg = wid * kper;
    for (int u = blockIdx.x; u < (N >> 4); u += gridDim.x) {
        f32x4 acc0 = {0.f, 0.f, 0.f, 0.f}, acc1 = {0.f, 0.f, 0.f, 0.f};
        const bf16* wrow = Wt + (size_t)(u * 16 + (lane & 15)) * K + kbeg + 8 * (lane >> 4);
        const bf16* a0 = A + (size_t)(lane & 15) * K + kbeg + 8 * (lane >> 4);
        const bf16* a1 = a0 + (size_t)16 * K;
#pragma unroll 4
        for (int k = 0; k < kper; k += 32) {
            const bf16x8 b = *(const bf16x8*)(wrow + k), x0 = *(const bf16x8*)(a0 + k), x1 = *(const bf16x8*)(a1 + k);
            acc0 = __builtin_amdgcn_mfma_f32_16x16x32_bf16(x0, b, acc0, 0, 0, 0);
            acc1 = __builtin_amdgcn_mfma_f32_16x16x32_bf16(x1, b, acc1, 0, 0, 0);
        }
        *(LAS f32x4*)(red + ((wid * 2 + 0) * 64 + lane) * 4) = acc0;
        *(LAS f32x4*)(red + ((wid * 2 + 1) * 64 + lane) * 4) = acc1;
        __syncthreads();
        { const int row = tid >> 4, col = tid & 15, mb = row >> 4, rr = row & 15, ln = col + 16 * (rr >> 2), rg = rr & 3; float s = 0.f;
#pragma unroll
          for (int w = 0; w < 8; ++w) s += red[((w * 2 + mb) * 64 + ln) * 4 + rg];
          E(row, u * 16 + col, s); }
        __syncthreads();
    }
}

constexpr int SKA_STRIDE = 2064, SKA_RSTD = 32 * SKA_STRIDE, SKA_RED = SKA_RSTD + 512;
template <class Epi>
__device__ __forceinline__ void skinny_gemm_hs(LAS unsigned char* lds, const float* __restrict__ HS, const bf16* __restrict__ Wt, int N, const Epi& E) {
    int tid_l = threadIdx.x; asm volatile("" : "+v"(tid_l)); const int tid = tid_l, lane = tid & 63, wid = tid >> 6;
    if ((int)blockIdx.x >= (N >> 4)) return;
    LAS float* rstd_l = (LAS float*)(lds + SKA_RSTD); LAS float* red = (LAS float*)(lds + SKA_RED);
    { const int row = tid >> 4, c16 = tid & 15; const float* src = HS + row * DM + c16 * 64; float ss = 0.f;
#pragma unroll
      for (int i = 0; i < 16; i += 2) { const f32x4 a = *(const f32x4*)(src + 4 * i), b = *(const f32x4*)(src + 4 * i + 4);
          ss += (a.x * a.x + a.y * a.y) + (a.z * a.z + a.w * a.w) + (b.x * b.x + b.y * b.y) + (b.z * b.z + b.w * b.w);
          v4u w; w.x = pk2(a.x, a.y); w.y = pk2(a.z, a.w); w.z = pk2(b.x, b.y); w.w = pk2(b.z, b.w);
          *(LAS v4u*)(lds + row * SKA_STRIDE + (c16 * 64 + 4 * i) * 2) = w; }
      ss += __shfl_xor(ss, 1); ss += __shfl_xor(ss, 2); ss += __shfl_xor(ss, 4); ss += __shfl_xor(ss, 8);
      if (c16 == 0) rstd_l[row] = rsqrtf(ss * (1.f / DM) + EPS); }
    __syncthreads();
    const int kbeg = wid * 128;
    for (int u = blockIdx.x; u < (N >> 4); u += gridDim.x) {
        f32x4 acc0 = {0.f, 0.f, 0.f, 0.f}, acc1 = {0.f, 0.f, 0.f, 0.f};
        const bf16* wrow = Wt + (size_t)(u * 16 + (lane & 15)) * DM + kbeg + 8 * (lane >> 4);
        const LAS unsigned char* a0 = lds + (lane & 15) * SKA_STRIDE + (kbeg + 8 * (lane >> 4)) * 2;
#pragma unroll
        for (int k = 0; k < 128; k += 32) {
            const bf16x8 b = *(const bf16x8*)(wrow + k), x0 = *(const LAS bf16x8*)(a0 + 2 * k), x1 = *(const LAS bf16x8*)(a0 + 16 * SKA_STRIDE + 2 * k);
            acc0 = __builtin_amdgcn_mfma_f32_16x16x32_bf16(x0, b, acc0, 0, 0, 0);
            acc1 = __builtin_amdgcn_mfma_f32_16x16x32_bf16(x1, b, acc1, 0, 0, 0);
        }
        *(LAS f32x4*)(red + ((wid * 2 + 0) * 64 + lane) * 4) = acc0;
        *(LAS f32x4*)(red + ((wid * 2 + 1) * 64 + lane) * 4) = acc1;
        __syncthreads();
        { const int row = tid >> 4, col = tid & 15, mb = row >> 4, rr = row & 15, ln = col + 16 * (rr >> 2), rg = rr & 3; float s = 0.f;
#pragma unroll
          for (int w = 0; w < 8; ++w) s += red[((w * 2 + mb) * 64 + ln) * 4 + rg];
          E(row, u * 16 + col, s * rstd_l[row]); }
        __syncthreads();
    }
}
struct SkUV { float* usu; float* vsf; __device__ __forceinline__ void operator()(int r, int c, float s) const { if (c < DM) usu[r * DM + c] = s; else vsf[r * DM + c - DM] = s; } };
struct SkResid { float* hs; __device__ __forceinline__ void operator()(int r, int c, float s) const { hs[r * DM + c] += s; } };
struct SkSqRelu { bf16* h; __device__ __forceinline__ void operator()(int r, int c, float s) const { const float a = fmaxf(s, 0.f); h[r * FF + c] = (bf16)(pk2(a * a, 0.f) & 0xffffu); } };
struct SkKVQG { float* out; float* qs; float* gs; const float* bg; int col_off;
    __device__ __forceinline__ void operator()(int r, int c0, float s) const { const int c = c0 + col_off;
        if (c < 512) out[O_CMPS + r * 512 + c] = s;
        else if (c < 1024) out[O_SELS + r * 512 + c - 512] = s;
        else if (c < 1536) out[O_WINS + (size_t)(r * 512 + 511) * 512 + c - 1024] = s;
        else if (c < 2560) qs[r * DM + c - 1536] = s * C2;
        else if (c < 2608) gs[r * 48 + c - 2560] = 1.f / (1.f + __expf(-(s + bg[c - 2560]))); } };

__device__ const unsigned char NSA_QB[128] = {116, 72, 42, 6, 119, 63, 51, 3, 106, 89, 39, 2, 123, 55, 49, 9, 112, 83, 34, 7, 114, 60, 57, 5, 110, 81, 31, 14, 115, 75, 38, 8, 108, 90, 28, 10, 98, 86, 52, 0, 111, 67, 54, 4, 100, 85, 50, 1, 125, 59, 36, 16, 124, 61, 32, 19, 127, 58, 27, 24, 117, 62, 45, 12, 120, 84, 47, 21, 105, 93, 48, 26, 121, 78, 40, 33, 99, 87, 66, 20, 107, 71, 69, 25, 101, 96, 53, 22, 113, 74, 68, 17, 97, 80, 77, 18, 122, 64, 56, 30, 95, 91, 73, 13, 103, 94, 46, 29, 102, 79, 76, 15, 109, 82, 70, 11, 126, 65, 44, 37, 104, 92, 41, 35, 118, 88, 43, 23};
struct Frame {
    LAS unsigned char* lds; volatile LAS unsigned* MISC;
    int tid, lane, wave, G, gw, NGW;
    unsigned char* ws; float* out;
};
constexpr int PTAB_OFF = LDSCTL_OFF + 1024;
__device__ __forceinline__ const void* tab_ptr(LAS unsigned char* lds, int i) {
    const unsigned long long v = *(volatile LAS unsigned long long*)(lds + PTAB_OFF + 8 * i);
    const unsigned lo = __builtin_amdgcn_readfirstlane((unsigned)v), hi = __builtin_amdgcn_readfirstlane((unsigned)(v >> 32));
    const GAS char* gp = (const GAS char*)(((unsigned long long)hi << 32) | lo);
    return (const void*)gp;
}
#define INF(i) ((const float*)tab_ptr(F.lds, (i)))

struct TTask { const float* W; int ld, col0, ncols; const float* gain; bf16* dst; int K, npad, ilv; };
__device__ __forceinline__ void transpose_item(const TTask& T, LAS float* scr, int item, int lane) {
    const int nblk = T.npad >> 5, kb = item / nblk, nb = item - kb * nblk, k0 = 64 * kb, n0 = 32 * nb;
    const int n = n0 + (lane & 31); const bool ok = n < T.ncols;
    const int k0d = T.ilv ? ((kb & 15) * 128 + (kb >> 4) * 64) : k0;
    float wv[32];
#pragma unroll
    for (int i = 0; i < 32; ++i) { const int kk = 2 * i + (lane >> 5); wv[i] = ok ? T.W[(size_t)(k0 + kk) * T.ld + T.col0 + n] : 0.f; }
#pragma unroll
    for (int i = 0; i < 32; ++i) { const int kk = 2 * i + (lane >> 5); float w = wv[i]; if (T.gain) w *= T.gain[k0 + kk]; scr[kk * 33 + (lane & 31)] = w; }
    LDS_WAIT(); asm volatile("" ::: "memory");
    const int c = lane & 7;
#pragma unroll
    for (int j = 0; j < 4; ++j) { const int nn = (lane >> 3) + 8 * j; const LAS float* s = scr + (8 * c) * 33 + nn;
        v4u o; o.x = pk2(s[0 * 33], s[1 * 33]); o.y = pk2(s[2 * 33], s[3 * 33]); o.z = pk2(s[4 * 33], s[5 * 33]); o.w = pk2(s[6 * 33], s[7 * 33]);
        *(v4u*)(T.dst + (size_t)(n0 + nn) * T.K + k0d + 8 * c) = o; }
    LDS_WAIT(); asm volatile("" ::: "memory");
}
constexpr int N_TTASK = 29;
__device__ __forceinline__ int get_ttask(Frame& F, int t, TTask& T) {
    unsigned char* ws = F.ws;
    if (t < 2)       { const int i = t;      T = TTask{INF(7) + (size_t)i * 1024 * 2048, 2048, 0, 2048, INF(6) + i * 1024, (bf16*)(ws + WS_WUV) + (size_t)i * 2048 * 1024, 1024, 2048}; }
    else if (t < 4)  { const int i = t - 2;  T = TTask{INF(11) + (size_t)i * 1024 * 1024, 1024, 0, 1024, nullptr, (bf16*)(ws + WS_WAO) + (size_t)i * 1024 * 1024, 1024, 1024}; }
    else if (t == 4) {                       T = TTask{INF(13), 1536, 0, 1536, INF(12), (bf16*)(ws + WS_WKVQG), 1024, 1536}; }
    else if (t == 5) {                       T = TTask{INF(21), 1072, 0, 1024, INF(20), (bf16*)(ws + WS_WKVQG) + (size_t)1536 * 1024, 1024, 1024}; }
    else if (t == 6) {                       T = TTask{INF(21), 1072, 1024, 48, INF(20), (bf16*)(ws + WS_WKVQG) + (size_t)2560 * 1024, 1024, 256}; }
    else if (t == 7) {                       T = TTask{INF(21) + (size_t)1024 * 1072, 1072, 0, 1024, INF(20) + 1024, (bf16*)(ws + WS_WQG1), 1024, 1024}; }
    else if (t == 8) {                       T = TTask{INF(21) + (size_t)1024 * 1072, 1072, 1024, 48, INF(20) + 1024, (bf16*)(ws + WS_WQG1) + (size_t)1024 * 1024, 1024, 256}; }
    else if (t < 11) { const int i = t - 9;  T = TTask{INF(23) + (size_t)i * 1024 * 1024, 1024, 0, 1024, nullptr, (bf16*)(ws + WS_WBO) + (size_t)i * 1024 * 1024, 1024, 1024}; }
    else if (t < 15) { const int i = t - 11; T = TTask{INF(25) + (size_t)i * 1024 * 4096, 4096, 0, 4096, INF(24) + i * 1024, (bf16*)(ws + WS_WUP) + (size_t)i * 4096 * 1024, 1024, 4096}; }
    else if (t < 19) { const int i = t - 15; T = TTask{INF(26) + (size_t)i * 4096 * 1024, 1024, 0, 1024, nullptr, (bf16*)(ws + WS_WDN) + (size_t)i * 1024 * 4096, 4096, 1024}; }
    else if (t < 23) { const int i = t - 19, kv = i >> 1, half = i & 1;
                       T = TTask{INF(kv ? 18 : 15) + (size_t)half * 1024 * 256, 256, 0, 256, nullptr, (bf16*)(ws + WS_WC1) + (size_t)kv * 512 * 1024 + (size_t)half * 256 * 1024, 1024, 256}; }
    else if (t < 25) { const int kv = t - 23; T = TTask{INF(kv ? 19 : 16), 64, 0, 64, nullptr, (bf16*)(ws + WS_WC2) + (size_t)kv * 64 * 256, 256, 64}; }
    else if (t < 27) { const int kv = t - 25; T = TTask{INF(kv ? 18 : 15), 256, 0, 256, nullptr, (bf16*)(ws + WS_WC1F) + (size_t)kv * 256 * 2048, 2048, 256, 1}; }
    else             { T = TTask{nullptr, 0, 0, 0, nullptr, nullptr, 64, 32}; return 0; }
    return (T.K >> 6) * (T.npad >> 5);
}
__device__ __forceinline__ void cvt_row_bf16_ssq(const float* xrow, bf16* orow, float* rs16, int lane) {
    const f32x4* xr = (const f32x4*)xrow + lane; f32x4 v[4]; float s = 0.f;
#pragma unroll
    for (int j = 0; j < 4; ++j) { v[j] = xr[64 * j]; s += (v[j].x * v[j].x + v[j].y * v[j].y) + (v[j].z * v[j].z + v[j].w * v[j].w); }
    s = wave_sum(s);
    unsigned long long* o8 = (unsigned long long*)orow + lane;
#pragma unroll
    for (int j = 0; j < 4; ++j) o8[64 * j] = (unsigned long long)pk2(v[j].x, v[j].y) | ((unsigned long long)pk2(v[j].z, v[j].w) << 32);
    if (lane < 16) rs16[lane] = lane == 0 ? s : 0.f;
}
__device__ __forceinline__ void norm_row_f32(const float* xrow, const float* g, float* orow, int lane) {
    const f32x4* xr = (const f32x4*)xrow + lane; const f32x4* gr = (const f32x4*)g + lane; f32x4 v[4]; float s = 0.f;
#pragma unroll
    for (int j = 0; j < 4; ++j) { v[j] = xr[64 * j]; s += (v[j].x * v[j].x + v[j].y * v[j].y) + (v[j].z * v[j].z + v[j].w * v[j].w); }
    const float rstd = rsqrtf(wave_sum(s) * (1.f / DM) + EPS);
#pragma unroll
    for (int j = 0; j < 4; ++j) { const f32x4 gg = gr[64 * j]; ((f32x4*)orow + lane)[64 * j] = v[j] * rstd * gg; }
}
__device__ __forceinline__ void norm_row_bf16(const bf16* xrow, const float* rs16, const float* g, float* orow, int lane) {
    const v4u a = *(const v4u*)(xrow + 8 * lane), b = *(const v4u*)(xrow + 512 + 8 * lane);
    float t = lane < 16 ? rs16[lane] : 0.f; t = wave_sum(t);
    const float rstd = rsqrtf(t * (1.f / DM) + EPS);
    const f32x4* gr = (const f32x4*)g; f32x4* o4 = (f32x4*)orow;
    const f32x4 g0 = gr[2 * lane], g1 = gr[2 * lane + 1], g2 = gr[128 + 2 * lane], g3 = gr[128 + 2 * lane + 1];
    o4[2 * lane]           = (f32x4){bf_lo(a.x), bf_hi(a.x), bf_lo(a.y), bf_hi(a.y)} * rstd * g0;
    o4[2 * lane + 1]       = (f32x4){bf_lo(a.z), bf_hi(a.z), bf_lo(a.w), bf_hi(a.w)} * rstd * g1;
    o4[128 + 2 * lane]     = (f32x4){bf_lo(b.x), bf_hi(b.x), bf_lo(b.y), bf_hi(b.y)} * rstd * g2;
    o4[128 + 2 * lane + 1] = (f32x4){bf_lo(b.z), bf_hi(b.z), bf_lo(b.w), bf_hi(b.w)} * rstd * g3;
}
__device__ __forceinline__ void prologue_phase(Frame& F) {
    LAS float* scr = (LAS float*)(F.lds + F.wave * 16384);
    for (int it = F.gw; ; it += F.NGW) {
        int r = it, t = 0; TTask T; int n = 0;
        for (; t < N_TTASK; ++t) { n = get_ttask(F, t, T); if (n == 0 || r < n) break; r -= n; }
        if (n == 0 || t >= N_TTASK) break;
        transpose_item(T, scr, r, F.lane);
    }
    { const float* Ws = INF(9); bf16* Wsb = (bf16*)(F.ws + WS_WSB);
      for (int i = F.gw * 64 + F.lane; i < 2 * 8 * 128 * 128; i += F.NGW * 64) { const int s = i & 127, t = (i >> 7) & 127; const float w = (s <= t) ? Ws[i] : 0.f; Wsb[i] = (bf16)(pk2(w, 0.f) & 0xffffu); } }
    { float* bias1 = (float*)(F.ws + WS_BIAS1);
      for (int o = F.gw; o < 512; o += F.NGW) { const int kv = o >> 8, n = o & 255; const float* pe = INF(kv ? 17 : 14); const float* w1 = INF(kv ? 18 : 15); float s = 0.f;
          for (int kk = F.lane; kk < 2048; kk += 64) s += pe[kk] * w1[(size_t)kk * 256 + n];
          s = wave_sum(s); if (F.lane == 0) bias1[o] = s; } }
    { const float* xp = INF(0); const float* xs = INF(1); bf16* XN = (bf16*)(F.ws + WS_XN); float* RS2 = (float*)(F.ws + WS_ROWSS2); float* HS = (float*)(F.ws + WS_HS);
      for (int m = F.gw; m < MP + NS; m += F.NGW) {
          if (m < MP) cvt_row_bf16_ssq(xp + (size_t)m * DM, XN + (size_t)m * DM, RS2 + (size_t)m * 16, F.lane);
          else { const int r = m - MP;
#pragma unroll
                 for (int j = 0; j < 4; ++j) ((f32x4*)(HS + (size_t)r * DM) + F.lane)[64 * j] = ((const f32x4*)(xs + (size_t)r * DM) + F.lane)[64 * j]; } } }
    { const float* cache = INF(2); const int* pt = (const int*)tab_ptr(F.lds, 5); bf16* acmp = (bf16*)(F.ws + WS_ACMP);
      for (int it = F.gw; it < NS * 512; it += F.NGW) { const int seq = it >> 9, jblk = it & 511; const int page = pt[seq * 64 + (jblk >> 3)];
          const float* src = cache + ((size_t)page * 128 + (jblk & 7) * 16) * 512;
#pragma unroll
          for (int i0 = 0; i0 < 32; i0 += 16) { f32x4 v[16];
#pragma unroll
              for (int j = 0; j < 16; ++j) v[j] = __builtin_nontemporal_load((const f32x4*)(src + (i0 + j) * 256 + F.lane * 4));
#pragma unroll
              for (int j = 0; j < 16; ++j) { const int i = i0 + j, r = i >> 1, kv = i & 1, g = F.lane >> 4, d = (F.lane & 15) * 4;
                  v2u w; w.x = pk2(v[j].x, v[j].y); w.y = pk2(v[j].z, v[j].w);
                  *(v2u*)(acmp + ((size_t)kv * ACMP_ROWS + (size_t)(it * 4 + g)) * 1024 + r * 64 + d) = w; } } } }
    { const float* st = INF(4); float* o = F.out + O_WINS;
      for (int it = F.gw * 4; it < NS * 511; it += F.NGW * 4) { f32x4 v[8];
#pragma unroll
          for (int j = 0; j < 4; ++j) { const int x = it + j < NS * 511 ? it + j : NS * 511 - 1, seq = x / 511, r = x - seq * 511;
              const f32x4* s4 = (const f32x4*)(st + (size_t)(seq * 512 + r + 1) * 512) + F.lane; v[2 * j] = s4[0]; v[2 * j + 1] = s4[64]; }
#pragma unroll
          for (int j = 0; j < 4; ++j) { const int x = it + j < NS * 511 ? it + j : NS * 511 - 1, seq = x / 511, r = x - seq * 511;
              f32x4* d4 = (f32x4*)(o + (size_t)(seq * 512 + r) * 512) + F.lane; d4[0] = v[2 * j]; d4[64] = v[2 * j + 1]; } } }
}

constexpr int GT_STRIDE = 272;
__device__ __forceinline__ void gating_phase(Frame& F, int layer, bf16* Uout) {
    bf16* U = (bf16*)(F.ws + WS_U); const bf16* V = (const bf16*)(F.ws + WS_V); const float* rowss = (const float*)(F.ws + WS_ROWSS);
    const bf16* Wsb = (const bf16*)(F.ws + WS_WSB) + (size_t)layer * 8 * 128 * 128;
    const float* gv = INF(8) + layer * DM; const float* bs = INF(10) + layer * 8 * 128;
    LAS unsigned char* vt = F.lds; LAS float* rstd_l = (LAS float*)(F.lds + 128 * GT_STRIDE);
    const int tid = F.tid, lane = F.lane, w = F.wave;
    for (int un = blockIdx.x; un < 1024; un += F.G) {
        const int chunk = un >> 3, g = un & 7, row0 = chunk * 128;
        if (tid < 128) { const float* p = rowss + (size_t)(row0 + tid) * 16; float s = 0.f;
#pragma unroll
            for (int i = 0; i < 16; ++i) s += p[i];
            rstd_l[tid] = rsqrtf(s * (1.f / DM) + EPS); }
        __syncthreads();
#pragma unroll
        for (int it = 0; it < 4; ++it) { const int idx = it * 512 + tid, r = idx >> 4, ch = idx & 15;
            v4u x = *(const v4u*)(V + (size_t)(row0 + r) * DM + g * 128 + ch * 8); const float rs = rstd_l[r];
            v4u y; y.x = pk2(bf_lo(x.x) * rs, bf_hi(x.x) * rs); y.y = pk2(bf_lo(x.y) * rs, bf_hi(x.y) * rs); y.z = pk2(bf_lo(x.z) * rs, bf_hi(x.z) * rs); y.w = pk2(bf_lo(x.w) * rs, bf_hi(x.w) * rs);
            *(LAS v4u*)(vt + r * GT_STRIDE + ch * 16) = y; }
        __syncthreads();
        f32x4 acc[8];
#pragma unroll
        for (int nt = 0; nt < 8; ++nt) acc[nt] = (f32x4){0.f, 0.f, 0.f, 0.f};
        const int kmax = (16 * w + 15) >> 5;
        const bf16* wrow = Wsb + ((size_t)g * 128 + 16 * w + (lane & 15)) * 128 + 8 * (lane >> 4);
        const int i16 = lane & 15, gidx = lane >> 4;
#pragma unroll
        for (int ks = 0; ks < 4; ++ks) if (ks <= kmax) {
            const bf16x8 wf = *(const bf16x8*)(wrow + 32 * ks);
            LAS unsigned char* vb = vt + (32 * ks + 8 * gidx + (i16 >> 2)) * GT_STRIDE + (4 * (i16 & 3)) * 2;
#pragma unroll
            for (int nt = 0; nt < 8; ++nt) {
                const s16x4 lo = __builtin_bit_cast(s16x4, __builtin_amdgcn_ds_read_tr16_b64_v4i16((LAS s16x4*)(vb + nt * 32)));
                const s16x4 hi = __builtin_bit_cast(s16x4, __builtin_amdgcn_ds_read_tr16_b64_v4i16((LAS s16x4*)(vb + nt * 32 + 4 * GT_STRIDE)));
                const bf16x8 vf = {lo[0], lo[1], lo[2], lo[3], hi[0], hi[1], hi[2], hi[3]};
                acc[nt] = __builtin_amdgcn_mfma_f32_16x16x32_bf16(vf, wf, acc[nt], 0, 0, 0);
            }
        }
        { const int tl = 16 * w + (lane & 15); const float bst = bs[g * 128 + tl]; const size_t ro = (size_t)(row0 + tl) * DM + g * 128 + 4 * (lane >> 4);
          v2u ux[8]; f32x4 gg[8];
#pragma unroll
          for (int nt = 0; nt < 8; ++nt) { ux[nt] = *(const v2u*)(U + ro + nt * 16); gg[nt] = *(const f32x4*)(gv + g * 128 + 4 * (lane >> 4) + nt * 16); }
          asm volatile("" ::: "memory");
#pragma unroll
          for (int nt = 0; nt < 8; ++nt) { const size_t o = ro + nt * 16;
              v2u r; r.x = pk2(bf_lo(ux[nt].x) * (acc[nt][0] * gg[nt].x + bst), bf_hi(ux[nt].x) * (acc[nt][1] * gg[nt].y + bst)); r.y = pk2(bf_lo(ux[nt].y) * (acc[nt][2] * gg[nt].z + bst), bf_hi(ux[nt].y) * (acc[nt][3] * gg[nt].w + bst));
              *(v2u*)(Uout + o) = r; } }
        __syncthreads();
    }
    if (blockIdx.x < NS) { const int r = blockIdx.x; const float* usu = (const float*)(F.ws + WS_USU) + r * DM; const float* vsf = (const float*)(F.ws + WS_VSF) + r * DM;
        bf16* uss = (bf16*)(F.ws + WS_USS) + r * DM; float* av = F.out + O_AV + (size_t)(layer * NS + r) * DM; const float* Ws = INF(9) + (size_t)layer * 8 * 128 * 128;
        LAS float* red = (LAS float*)F.lds;
        const float v0 = vsf[tid], v1 = vsf[tid + 512]; float s = wave_sum(v0 * v0 + v1 * v1);
        if (lane == 0) red[w] = s;
        __syncthreads();
        float tot = 0.f;
#pragma unroll
        for (int i = 0; i < 8; ++i) tot += red[i];
        const float rstd = rsqrtf(tot * (1.f / DM) + EPS);
#pragma unroll
        for (int h = 0; h < 2; ++h) { const int c = tid + 512 * h, g = c >> 7; const float vn = (h ? v1 : v0) * rstd * gv[c]; av[c] = vn;
            const float sg = Ws[(size_t)g * 128 * 128] * vn + bs[g * 128]; uss[c] = (bf16)(pk2(usu[c] * sg, 0.f) & 0xffffu); }
        __syncthreads();
    }
}

namespace nsa {
constexpr int KS = 144, VS = 192;
constexpr int KBUF = 64 * KS, VBUF = 64 * VS;
constexpr int L_K = 0, L_V = 2 * KBUF, L_IMPA = L_V + 2 * VBUF, IMP_LD = 132, L_IMPB = L_IMPA + 64 * IMP_LD * 4, L_K2 = 0, KBUF2 = 128 * KS, L_V2 = 2 * KBUF2, VBUF2 = 128 * VS, L_STASH = L_V2 + 2 * VBUF2, L_SELM = L_STASH + 8 * 4096, L_END = L_SELM + 64 * 16;
static_assert(L_SELM >= L_IMPB + 64 * IMP_LD * 4, "selection masks clear of the importance tables");
static_assert(L_END <= LDSCTL_OFF, "attention LDS map");
constexpr float NEG = -1e30f;
struct TileRegs { v4u k, v; };
__device__ __forceinline__ TileRegs tile_load(const bf16* Kp, const bf16* Vp, int stride, int row0, int rmax, int tid) {
    int r = row0 + (tid >> 3); r = r < 0 ? 0 : (r > rmax ? rmax : r); const int ch = tid & 7; TileRegs t;
    t.k = *(const v4u*)(Kp + (size_t)r * stride + ch * 8); t.v = *(const v4u*)(Vp + (size_t)r * stride + ch * 8); return t;
}
__device__ __forceinline__ void tile_store(LAS unsigned char* lds, int buf, const TileRegs& t, int tid) {
    const int r = tid >> 3, ch = tid & 7;
    *(LAS v4u*)(lds + L_K + buf * KBUF + r * KS + ch * 16) = t.k;
    *(LAS v4u*)(lds + L_V + buf * VBUF + r * VS + ch * 16) = t.v;
}
__device__ __forceinline__ void load_k_frags(bf16x8 (&kf)[8], const LAS unsigned char* kb, int r32, int hi) {
    const LAS unsigned char* ka = kb + r32 * KS + hi * 16;
#pragma unroll
    for (int d0 = 0; d0 < 4; ++d0) { kf[2 * d0] = *(const LAS bf16x8*)(ka + d0 * 32); kf[2 * d0 + 1] = *(const LAS bf16x8*)(ka + 32 * KS + d0 * 32); }
}
template <int HALF>
__device__ __forceinline__ void load_v_frags(bf16x8 (&vf)[8], const LAS unsigned char* vb, int lane) {
    const int g4 = lane >> 4, h = g4 >> 1, cb = g4 & 1, i = lane & 15;
    const LAS unsigned char* va = vb + (4 * h + (i >> 2)) * VS + (16 * cb + 4 * (i & 3)) * 2;
#pragma unroll
    for (int ks = 2 * HALF; ks < 2 * HALF + 2; ++ks)
#pragma unroll
        for (int db = 0; db < 2; ++db) { const LAS unsigned char* a = va + 16 * ks * VS + 64 * db;
            const s16x4 lo = __builtin_bit_cast(s16x4, __builtin_amdgcn_ds_read_tr16_b64_v4i16((LAS s16x4*)(a)));
            const s16x4 hi4 = __builtin_bit_cast(s16x4, __builtin_amdgcn_ds_read_tr16_b64_v4i16((LAS s16x4*)(a + 8 * VS)));
            vf[2 * ks + db] = (bf16x8){lo[0], lo[1], lo[2], lo[3], hi4[0], hi4[1], hi4[2], hi4[3]}; }
}
__device__ __forceinline__ void qk_mma(f32x16& p0, f32x16& p1, const bf16x8 (&kf)[8], const bf16x8 (&qr)[4], float m) {
    const f32x16 z = {0.f, 0.f, 0.f, 0.f, 0.f, 0.f, 0.f, 0.f, 0.f, 0.f, 0.f, 0.f, 0.f, 0.f, 0.f, 0.f};
    p0 = __builtin_amdgcn_mfma_f32_32x32x16_bf16(kf[0], qr[0], z, 0, 0, 0); p1 = __builtin_amdgcn_mfma_f32_32x32x16_bf16(kf[1], qr[0], z, 0, 0, 0);
#pragma unroll
    for (int d0 = 1; d0 < 4; ++d0) { p0 = __builtin_amdgcn_mfma_f32_32x32x16_bf16(kf[2 * d0], qr[d0], p0, 0, 0, 0); p1 = __builtin_amdgcn_mfma_f32_32x32x16_bf16(kf[2 * d0 + 1], qr[d0], p1, 0, 0, 0); }
    if (__any(m != 0.f)) {
#pragma unroll
        for (int r = 0; r < 16; ++r) { p0[r] -= m; p1[r] -= m; } }
}
__device__ __forceinline__ void mask_tile(f32x16& p0, f32x16& p1, int key0, int lo, int hi_lim, bool rowsel, int hi) {
    const int kb = key0 + 4 * hi;
#pragma unroll
    for (int r = 0; r < 16; ++r) { const int k = kb + (r & 3) + 8 * (r >> 2);
        p0[r] = (rowsel && k >= lo && k <= hi_lim) ? p0[r] : NEG;
        p1[r] = (rowsel && k + 32 >= lo && k + 32 <= hi_lim) ? p1[r] : NEG; }
}
__device__ __forceinline__ float tile_rowmax(const f32x16& p0, const f32x16& p1) {
    float a = fmaxf(p0[0], p1[0]);
#pragma unroll
    for (int r = 1; r < 16; ++r) a = fmaxf(a, fmaxf(p0[r], p1[r]));
    return swap_max(a);
}
__device__ __forceinline__ void pv_mma(f32x16& o0, f32x16& o1, const bf16x8 (&vf)[8], const f32x16& p0, const f32x16& p1, unsigned amask) {
#pragma unroll
    for (int hh = 0; hh < 2; ++hh)
#pragma unroll
        for (int s = 0; s < 2; ++s) {
            v4u pw;
            if (hh == 0) { pw.x = pk2(p0[8 * s + 0], p0[8 * s + 1]); pw.y = pk2(p0[8 * s + 2], p0[8 * s + 3]); pw.z = pk2(p0[8 * s + 4], p0[8 * s + 5]); pw.w = pk2(p0[8 * s + 6], p0[8 * s + 7]); }
            else         { pw.x = pk2(p1[8 * s + 0], p1[8 * s + 1]); pw.y = pk2(p1[8 * s + 2], p1[8 * s + 3]); pw.z = pk2(p1[8 * s + 4], p1[8 * s + 5]); pw.w = pk2(p1[8 * s + 6], p1[8 * s + 7]); }
            pw.x &= amask; pw.y &= amask; pw.z &= amask; pw.w &= amask;
            const bf16x8 pb = __builtin_bit_cast(bf16x8, pw);
            o0 = __builtin_amdgcn_mfma_f32_32x32x16_bf16(vf[2 * (2 * hh + s)], pb, o0, 0, 0, 0);
            o1 = __builtin_amdgcn_mfma_f32_32x32x16_bf16(vf[2 * (2 * hh + s) + 1], pb, o1, 0, 0, 0);
        }
}
__device__ __forceinline__ float soft_tile(f32x16& p0, f32x16& p1) {
    float s0 = 0.f, s1 = 0.f;
#pragma unroll
    for (int r = 0; r < 16; ++r) { p0[r] = fast_exp2(p0[r]); p1[r] = fast_exp2(p1[r]); s0 += p0[r]; s1 += p1[r]; }
    return s0 + s1;
}
constexpr float L_BIG = 1048576.f;
template <bool WITH_O>
__device__ __forceinline__ void ref_shift(float& m, float& l, f32x16& o0, f32x16& o1) {
    const float lm = swap_max(l);
    if (__any(lm > L_BIG)) { const float d = lm > L_BIG ? 20.f : 0.f, alpha = lm > L_BIG ? (1.f / L_BIG) : 1.f; m += d; l *= alpha;
        if (WITH_O) {
#pragma unroll
            for (int r = 0; r < 16; ++r) { o0[r] *= alpha; o1[r] *= alpha; } } }
}
template <bool MASKED>
__device__ __forceinline__ void att_step(const LAS unsigned char* kb, const LAS unsigned char* vb, const bf16x8 (&qr)[4], float& m, float& l, f32x16& o0, f32x16& o1,
                                         int key0, int lo, int hi_lim, bool rsel, int r32, int hi, int lane) {
    f32x16 p0, p1; bf16x8 kf[8], vf[8];
    load_k_frags(kf, kb, r32, hi); load_v_frags<0>(vf, vb, lane);
    __builtin_amdgcn_sched_barrier(0);
    qk_mma(p0, p1, kf, qr, m);
    __builtin_amdgcn_sched_barrier(0);
    load_v_frags<1>(vf, vb, lane);
    __builtin_amdgcn_sched_barrier(0);
    if (MASKED) mask_tile(p0, p1, key0, lo, hi_lim, rsel, hi);
    float s = soft_tile(p0, p1);
    if (!MASKED) s = rsel ? s : 0.f;
    l += s;
    pv_mma(o0, o1, vf, p0, p1, (MASKED || rsel) ? 0xffffffffu : 0u);
    ref_shift<true>(m, l, o0, o1);
}
#define NSA_SB __builtin_amdgcn_sched_barrier(0)
#define NSA_EXP4(P, B, S) do { P[(B)] = fast_exp2(P[(B)]); P[(B) + 1] = fast_exp2(P[(B) + 1]); P[(B) + 2] = fast_exp2(P[(B) + 2]); P[(B) + 3] = fast_exp2(P[(B) + 3]); S += (P[(B)] + P[(B) + 1]) + (P[(B) + 2] + P[(B) + 3]); } while (0)
#define NSA_PACK8(P, B, W, MASK) do { W.x = pk2(P[(B) + 0], P[(B) + 1]) & (MASK); W.y = pk2(P[(B) + 2], P[(B) + 3]) & (MASK); W.z = pk2(P[(B) + 4], P[(B) + 5]) & (MASK); W.w = pk2(P[(B) + 6], P[(B) + 7]) & (MASK); } while (0)
#define NSA_MF(D, A, Bq) D = __builtin_amdgcn_mfma_f32_32x32x16_bf16(A, Bq, D, 0, 0, 0)
#define NSA_PVS(VF, W, I) do { const bf16x8 pb_ = __builtin_bit_cast(bf16x8, W); NSA_MF(o0, VF[2 * (I)], pb_); NSA_MF(o1, VF[2 * (I) + 1], pb_); } while (0)
__device__ __forceinline__ void att_step2(const LAS unsigned char* kba, const LAS unsigned char* vba, const LAS unsigned char* kbb, const LAS unsigned char* vbb, const bf16x8 (&qr)[4],
                                          float& m, float& l, f32x16& o0, f32x16& o1, bool rsela, bool rselb, int r32, int hi, int lane) {
    f32x16 pa0, pa1, pb0, pb1; bf16x8 kf[8], vfa[8], vfb[8];
    const f32x16 z = {0.f, 0.f, 0.f, 0.f, 0.f, 0.f, 0.f, 0.f, 0.f, 0.f, 0.f, 0.f, 0.f, 0.f, 0.f, 0.f};
    const unsigned ma = rsela ? 0xffffffffu : 0u, mb = rselb ? 0xffffffffu : 0u;
    const LAS unsigned char* kab = kbb + r32 * KS + hi * 16;
    load_k_frags(kf, kba, r32, hi);
    NSA_SB;
    pa0 = __builtin_amdgcn_mfma_f32_32x32x16_bf16(kf[0], qr[0], z, 0, 0, 0); pa1 = __builtin_amdgcn_mfma_f32_32x32x16_bf16(kf[1], qr[0], z, 0, 0, 0);
    NSA_MF(pa0, kf[2], qr[1]); NSA_MF(pa1, kf[3], qr[1]); NSA_MF(pa0, kf[4], qr[2]); NSA_MF(pa1, kf[5], qr[2]); NSA_MF(pa0, kf[6], qr[3]); NSA_MF(pa1, kf[7], qr[3]);
    NSA_SB;
#pragma unroll
    for (int d0 = 0; d0 < 4; ++d0) kf[2 * d0] = *(const LAS bf16x8*)(kab + d0 * 32);
    NSA_SB;
    float sa0 = 0.f, sb0 = 0.f; v4u wa0, wa1, wa2, wa3, wb0, wb1, wb2, wb3;
    pb0 = __builtin_amdgcn_mfma_f32_32x32x16_bf16(kf[0], qr[0], z, 0, 0, 0); NSA_SB; NSA_EXP4(pa0, 0, sa0); NSA_SB;
    NSA_MF(pb0, kf[2], qr[1]); NSA_SB; NSA_EXP4(pa0, 4, sa0); NSA_PACK8(pa0, 0, wa0, ma); NSA_SB;
#pragma unroll
    for (int d0 = 0; d0 < 4; ++d0) kf[2 * d0 + 1] = *(const LAS bf16x8*)(kab + 32 * KS + d0 * 32);
    NSA_SB;
    NSA_MF(pb0, kf[4], qr[2]); NSA_SB; NSA_EXP4(pa0, 8, sa0); NSA_SB;
    NSA_MF(pb0, kf[6], qr[3]); NSA_SB; NSA_EXP4(pa0, 12, sa0); NSA_PACK8(pa0, 8, wa1, ma); NSA_SB;
    pb1 = __builtin_amdgcn_mfma_f32_32x32x16_bf16(kf[1], qr[0], z, 0, 0, 0); NSA_SB; NSA_EXP4(pa1, 0, sa0); NSA_SB;
    NSA_MF(pb1, kf[3], qr[1]); NSA_SB; NSA_EXP4(pa1, 4, sa0); NSA_PACK8(pa1, 0, wa2, ma); NSA_SB;
    NSA_MF(pb1, kf[5], qr[2]); NSA_SB; NSA_EXP4(pa1, 8, sa0); NSA_SB;
    NSA_MF(pb1, kf[7], qr[3]); NSA_SB; NSA_EXP4(pa1, 12, sa0); NSA_PACK8(pa1, 8, wa3, ma); NSA_SB;
    load_v_frags<0>(vfa, vba, lane);
    NSA_SB;
    NSA_PVS(vfa, wa0, 0); NSA_SB; load_v_frags<1>(vfa, vba, lane); NSA_EXP4(pb0, 0, sb0); NSA_EXP4(pb0, 4, sb0); NSA_PACK8(pb0, 0, wb0, mb); NSA_SB;
    NSA_PVS(vfa, wa1, 1); NSA_SB; NSA_EXP4(pb0, 8, sb0); NSA_EXP4(pb0, 12, sb0); NSA_PACK8(pb0, 8, wb1, mb); NSA_SB;
    NSA_PVS(vfa, wa2, 2); NSA_SB; load_v_frags<0>(vfb, vbb, lane); NSA_EXP4(pb1, 0, sb0); NSA_EXP4(pb1, 4, sb0); NSA_PACK8(pb1, 0, wb2, mb); NSA_SB;
    NSA_PVS(vfa, wa3, 3); NSA_SB; load_v_frags<1>(vfb, vbb, lane); NSA_EXP4(pb1, 8, sb0); NSA_EXP4(pb1, 12, sb0); NSA_PACK8(pb1, 8, wb3, mb); NSA_SB;
    NSA_PVS(vfb, wb0, 0); NSA_PVS(vfb, wb1, 1); NSA_PVS(vfb, wb2, 2); NSA_PVS(vfb, wb3, 3);
    NSA_SB;
    l += (rsela ? sa0 : 0.f) + (rselb ? sb0 : 0.f);
    ref_shift<true>(m, l, o0, o1);
}
__device__ __forceinline__ void topk_finish(bool c0, bool c1, unsigned u0, unsigned u1, unsigned T, bool exact, int need, int lane, bool& s0, bool& s1) {
    if (exact) { s0 = c0 && u0 >= T; s1 = c1 && u1 >= T; return; }
    const bool g0 = c0 && u0 > T, g1 = c1 && u1 > T, e0 = c0 && u0 == T, e1 = c1 && u1 == T;
    const int rem = need - (__popcll(__ballot(g0)) + __popcll(__ballot(g1)));
    const unsigned long long be0 = __ballot(e0), be1 = __ballot(e1), below = (1ull << lane) - 1ull;
    const int r0 = __popcll(be0 & below), r1 = __popcll(be0) + __popcll(be1 & below);
    s0 = g0 || (e0 && r0 < rem); s1 = g1 || (e1 && r1 < rem);
}
__device__ __forceinline__ void topk_select2(bool c0a, bool c1a, unsigned u0a, unsigned u1a, bool c0b, bool c1b, unsigned u0b, unsigned u1b, int need, int lane, bool& s0a, bool& s1a, bool& s0b, bool& s1b) {
    const int ncand = __popcll(__ballot(c0a)) + __popcll(__ballot(c1a));
    if (ncand <= need) { s0a = c0a; s1a = c1a; s0b = c0b; s1b = c1b; return; }
    u0a = c0a ? u0a : 0u; u1a = c1a ? u1a : 0u; u0b = c0b ? u0b : 0u; u1b = c1b ? u1b : 0u;
    unsigned Ta = 0u, Tb = 0u; bool xa = false, xb = false;
    for (int bit = 30; bit >= 0; --bit) {
        const unsigned Tna = Ta | (1u << bit), Tnb = Tb | (1u << bit);
        const int ca = __popcll(__ballot(u0a >= Tna)) + __popcll(__ballot(u1a >= Tna)), cb = __popcll(__ballot(u0b >= Tnb)) + __popcll(__ballot(u1b >= Tnb));
        if (!xa) { if (ca >= need) Ta = Tna; xa = ca == need; }
        if (!xb) { if (cb >= need) Tb = Tnb; xb = cb == need; }
        if (xa && xb) break;
    }
    topk_finish(c0a, c1a, u0a, u1a, Ta, xa, need, lane, s0a, s1a);
    topk_finish(c0b, c1b, u0b, u1b, Tb, xb, need, lane, s0b, s1b);
}
__device__ __forceinline__ void topk_select(bool c0, bool c1, unsigned u0, unsigned u1, int need, int lane, bool& s0, bool& s1) {
    bool d0, d1; topk_select2(c0, c1, u0, u1, c0, c1, u0, u1, need, lane, s0, s1, d0, d1);
}

struct TileSrc { const bf16* K; const bf16* V; int stride, row0, rmax; };
struct Tile2Regs { v4u k0, k1, v0, v1; };
__device__ __forceinline__ Tile2Regs tile2_load(const bf16* Kp, const bf16* Vp, int row0, int tid) {
    int r = row0 + (tid >> 2); r = r > SEQ - 1 ? SEQ - 1 : r; const int c = (tid & 3) * 16; Tile2Regs t;
    const bf16* kp = Kp + (size_t)r * 512 + c; const bf16* vp = Vp + (size_t)r * 512 + c;
    t.k0 = *(const v4u*)kp; t.k1 = *(const v4u*)(kp + 8); t.v0 = *(const v4u*)vp; t.v1 = *(const v4u*)(vp + 8); return t;
}
__device__ __forceinline__ void tile2_store(LAS unsigned char* lds, int buf, const Tile2Regs& t, int tid) {
    const int r = tid >> 2, c = (tid & 3) * 32;
    *(LAS v4u*)(lds + L_K2 + buf * KBUF2 + r * KS + c) = t.k0; *(LAS v4u*)(lds + L_K2 + buf * KBUF2 + r * KS + c + 16) = t.k1;
    *(LAS v4u*)(lds + L_V2 + buf * VBUF2 + r * VS + c) = t.v0; *(LAS v4u*)(lds + L_V2 + buf * VBUF2 + r * VS + c + 16) = t.v1;
}
__device__ __forceinline__ void nsa_unit(const bf16* __restrict__ Q, const float* __restrict__ gates, const bf16* __restrict__ kc, const bf16* __restrict__ vc,
                                         const bf16* __restrict__ ksel, const bf16* __restrict__ kwin, bf16* __restrict__ O, int b, int g, int qb, LAS unsigned char* lds) {
    int tid_l = threadIdx.x; asm volatile("" : "+v"(tid_l)); const int tid = tid_l, lane = tid & 63, r32 = lane & 31, hi = lane >> 5, wid = __builtin_amdgcn_readfirstlane(tid >> 6);
    const int t0 = qb * 64, cur = qb, ql = 8 * wid + (r32 >> 2), tq = t0 + ql, head = 4 * g + (r32 & 3);
    const size_t qrow = (size_t)b * SEQ + tq;
    bf16x8 qr[4];
#pragma unroll
    for (int d0 = 0; d0 < 4; ++d0) qr[d0] = *(const bf16x8*)(Q + qrow * DM + head * 64 + 16 * d0 + 8 * hi);
    f32x16 ob0, ob1;
    LAS unsigned* stash = (LAS unsigned*)(lds + L_STASH) + wid * 1024 + lane;
    LAS float* impA = (LAS float*)(lds + L_IMPA); LAS float* impB = (LAS float*)(lds + L_IMPB); LAS unsigned long long* selm = (LAS unsigned long long*)(lds + L_SELM);
    const int nct = (((t0 + 32) >> 4) >> 6) + 1, cmax_q = (tq - 31) >> 4, cmax_w = (t0 + 8 * wid - 31) >> 4;
    const bf16* Kc = kc + (size_t)b * 512 * 256 + g * 64; const bf16* Vc = vc + (size_t)b * 512 * 256 + g * 64;
    float m = 0.f, l = 0.f, inv = 0.f;
#pragma unroll
    for (int r = 0; r < 16; ++r) { ob0[r] = 0.f; ob1[r] = 0.f; }
    { const int nd1 = (nct + 1) >> 1; TileRegs r1;
      r1 = tile_load(Kc, Kc + 64 * 256, 256, 0, 511, tid);
      { const int r = tid >> 3, ch = tid & 7; *(LAS v4u*)(lds + L_K + r * KS + ch * 16) = r1.k; *(LAS v4u*)(lds + L_V + r * KS + ch * 16) = r1.v; }
      __syncthreads();
      for (int s = 0; s < nd1; ++s) { const int buf = s & 1, ta = 2 * s, tb = ta + 1;
        if (s + 1 < nd1) r1 = tile_load(Kc, Kc + 64 * 256, 256, 128 * (s + 1), 511, tid); else r1 = tile_load(Kc, Vc, 256, 0, 511, tid);
        const LAS unsigned char* kba = lds + L_K + buf * KBUF; const LAS unsigned char* kbb = lds + L_V + buf * VBUF;
        { f32x16 pa0, pa1; bf16x8 kf[8]; load_k_frags(kf, kba, r32, hi); __builtin_amdgcn_sched_barrier(0); qk_mma(pa0, pa1, kf, qr, m); __builtin_amdgcn_sched_barrier(0);
          if (tb < nct) { f32x16 pb0, pb1; load_k_frags(kf, kbb, r32, hi); __builtin_amdgcn_sched_barrier(0); qk_mma(pb0, pb1, kf, qr, m); __builtin_amdgcn_sched_barrier(0);
              if (64 * ta + 63 > cmax_w) { asm volatile("; boundary tile" ::: "memory"); mask_tile(pa0, pa1, 64 * ta, 0, cmax_q, true, hi); }
              if (64 * tb + 63 > cmax_w) { asm volatile("; boundary tile" ::: "memory"); mask_tile(pb0, pb1, 64 * tb, 0, cmax_q, true, hi); }
              const float sa_ = soft_tile(pa0, pa1); const float sb_ = soft_tile(pb0, pb1); l += sa_ + sb_; }
          else { if (64 * ta + 63 > cmax_w) { asm volatile("; boundary tile" ::: "memory"); mask_tile(pa0, pa1, 64 * ta, 0, cmax_q, true, hi); }
              const float sa_ = soft_tile(pa0, pa1); l += sa_; }
          ref_shift<false>(m, l, ob0, ob1); }
        if (s + 1 < nd1) { const int r = tid >> 3, ch = tid & 7; *(LAS v4u*)(lds + L_K + (buf ^ 1) * KBUF + r * KS + ch * 16) = r1.k; *(LAS v4u*)(lds + L_V + (buf ^ 1) * VBUF + r * KS + ch * 16) = r1.v; }
        else tile_store(lds, buf ^ 1, r1, tid);
        __syncthreads(); }
      l = swap_sum(l); inv = l > 0.f ? 1.f / l : 0.f;
      for (int ti = 0; ti < nct; ++ti) { const int buf = (nd1 + ti) & 1;
        if (ti + 1 < nct) r1 = tile_load(Kc, Vc, 256, 64 * (ti + 1), 511, tid);
        const LAS unsigned char* kb = lds + L_K + buf * KBUF; const LAS unsigned char* vb = lds + L_V + buf * VBUF;
        { f32x16 p0, p1; bf16x8 kf[8], vf[8]; load_k_frags(kf, kb, r32, hi); load_v_frags<0>(vf, vb, lane); __builtin_amdgcn_sched_barrier(0); qk_mma(p0, p1, kf, qr, m); __builtin_amdgcn_sched_barrier(0); load_v_frags<1>(vf, vb, lane); __builtin_amdgcn_sched_barrier(0);
            if (64 * ti + 63 > cmax_w) { asm volatile("; boundary tile" ::: "memory"); mask_tile(p0, p1, 64 * ti, 0, cmax_q, true, hi); }
#pragma unroll
            for (int r = 0; r < 16; ++r) { p0[r] = fast_exp2(p0[r]) * inv; p1[r] = fast_exp2(p1[r]) * inv; }
#pragma unroll
            for (int hh = 0; hh < 2; ++hh)
#pragma unroll
                for (int gi = 0; gi < 4; ++gi) { float P[4];
#pragma unroll
                    for (int e = 0; e < 4; ++e) P[e] = quad_sum(hh ? p1[4 * gi + e] : p0[4 * gi + e]);
                    if ((r32 & 3) == 0) { const int j = 16 * ti + 8 * hh + 2 * gi + hi; impA[ql * IMP_LD + j] = 2.f * (P[0] + P[1] + P[2]) + P[3]; impB[ql * IMP_LD + j + 1] = P[3]; } }
            pv_mma(ob0, ob1, vf, p0, p1, 0xffffffffu); }
        if (ti + 1 < nct) tile_store(lds, buf ^ 1, r1, tid);
        __syncthreads(); } }
    const bf16* Ks = ksel + (size_t)b * SEQ * 512 + g * 64; const bf16* Kw = kwin + (size_t)b * SEQ * 512 + g * 64;
    Tile2Regs r2 = tile2_load(Ks, Ks + 256, 0, tid);
    unsigned long long wlo = 0ull, whi = 0ull;
    { const int nforced = cur >= 2 ? 3 : cur + 1, need = 16 - nforced;
      for (int qi = 0; qi < 8; qi += 2) { const int qa = 8 * wid + qi, qb_ = qa + 1; const int j0 = lane, j1 = lane + 64;
          const bool c0 = j0 >= 1 && j0 <= cur - 2, c1 = j1 <= cur - 2;
          const float v0a = c0 ? impA[qa * IMP_LD + j0] + impB[qa * IMP_LD + j0] : 0.f, v1a = c1 ? impA[qa * IMP_LD + j1] + impB[qa * IMP_LD + j1] : 0.f;
          const float v0b = c0 ? impA[qb_ * IMP_LD + j0] + impB[qb_ * IMP_LD + j0] : 0.f, v1b = c1 ? impA[qb_ * IMP_LD + j1] + impB[qb_ * IMP_LD + j1] : 0.f;
          bool s0a, s1a, s0b, s1b; topk_select2(c0, c1, __float_as_uint(v0a), __float_as_uint(v1a), c0, c1, __float_as_uint(v0b), __float_as_uint(v1b), need, lane, s0a, s1a, s0b, s1b);
          const bool f0 = j0 == 0 || j0 == cur || j0 == cur - 1, f1 = j1 == cur || j1 == cur - 1;
          const unsigned long long a0 = __ballot(s0a || f0), a1 = __ballot(s1a || f1), b0 = __ballot(s0b || f0), b1 = __ballot(s1b || f1);
          if (lane == 0) { selm[qa * 2 + 0] = a0; selm[qa * 2 + 1] = a1; selm[qb_ * 2 + 0] = b0; selm[qb_ * 2 + 1] = b1; } }
      __syncthreads();
      tile2_store(lds, 0, r2, tid);
#pragma unroll
      for (int i = 0; i < 8; ++i) { wlo |= selm[(8 * wid + i) * 2 + 0]; whi |= selm[(8 * wid + i) * 2 + 1]; }
      wlo = ((unsigned long long)__builtin_amdgcn_readfirstlane((unsigned)(wlo >> 32)) << 32) | (unsigned)__builtin_amdgcn_readfirstlane((unsigned)wlo);
      whi = ((unsigned long long)__builtin_amdgcn_readfirstlane((unsigned)(whi >> 32)) << 32) | (unsigned)__builtin_amdgcn_readfirstlane((unsigned)whi);
      const float gt0 = gates[qrow * 48 + head * 3 + 0];
#pragma unroll
      for (int r = 0; r < 16; ++r) { stash[64 * r] = pk2(gt0 * ob0[r], gt0 * ob1[r]); ob0[r] = 0.f; ob1[r] = 0.f; }
      m = 0.f; l = 0.f;
      __syncthreads(); }
    { const int nd = (cur >> 1) + 1;
      for (int dt = 0; dt < nd; ++dt) { const int buf = dt & 1;
          if (dt + 1 < nd) r2 = tile2_load(Ks, Ks + 256, 128 * (dt + 1), tid);
          { const int ja = 2 * dt, jb = ja + 1;
            const bool na = (((ja < 64 ? wlo : whi) >> (ja & 63)) & 1ull) != 0ull, nb = jb < cur && (((jb < 64 ? wlo : whi) >> (jb & 63)) & 1ull) != 0ull;
            if (na && nb && !__any(m != 0.f)) { const unsigned long long mq = selm[ql * 2 + (ja >> 6)]; const bool rsa = ((mq >> (ja & 63)) & 1ull) != 0ull, rsb = ((mq >> (jb & 63)) & 1ull) != 0ull;
                att_step2(lds + L_K2 + buf * KBUF2, lds + L_V2 + buf * VBUF2, lds + L_K2 + buf * KBUF2 + 64 * KS, lds + L_V2 + buf * VBUF2 + 64 * VS, qr, m, l, ob0, ob1, rsa, rsb, r32, hi, lane); }
            else {
#pragma unroll
          for (int sub = 0; sub < 2; ++sub) { const int j = 2 * dt + sub;
              const bool wneed = j <= cur && (((j < 64 ? wlo : whi) >> (j & 63)) & 1ull) != 0ull;
              if (wneed) { const bool rsel = ((selm[ql * 2 + (j >> 6)] >> (j & 63)) & 1ull) != 0ull;
                  const LAS unsigned char* kb = lds + L_K2 + buf * KBUF2 + sub * 64 * KS; const LAS unsigned char* vb = lds + L_V2 + buf * VBUF2 + sub * 64 * VS;
                  if (j == cur) att_step<true>(kb, vb, qr, m, l, ob0, ob1, 64 * j, 0, tq, rsel, r32, hi, lane);
                  else att_step<false>(kb, vb, qr, m, l, ob0, ob1, 64 * j, 0, tq, rsel, r32, hi, lane); } } } }
          if (dt + 1 < nd) tile2_store(lds, buf ^ 1, r2, tid);
          __syncthreads(); }
      int tidB_l = threadIdx.x; asm volatile("" : "+v"(tidB_l));
      const int laneB = tidB_l & 63, r32B = laneB & 31, widB = __builtin_amdgcn_readfirstlane(tidB_l >> 6), headB = 4 * g + (r32B & 3); const size_t qrowB = (size_t)b * SEQ + t0 + 8 * widB + (r32B >> 2);
      l = swap_sum(l); const float gt1 = gates[qrowB * 48 + headB * 3 + 1]; const float sc = l > 0.f ? gt1 / l : 0.f;
#pragma unroll
      for (int r = 0; r < 16; ++r) { const unsigned u = stash[64 * r]; stash[64 * r] = pk2(bf_lo(u) + sc * ob0[r], bf_hi(u) + sc * ob1[r]); ob0[r] = 0.f; ob1[r] = 0.f; }
      m = 0.f; l = 0.f; }
    int tidC_l = threadIdx.x; asm volatile("" : "+v"(tidC_l));
    const int tidC = tidC_l, laneC = tidC & 63, r32C = laneC & 31, hiC = laneC >> 5, widC = __builtin_amdgcn_readfirstlane(tidC >> 6), tqC = t0 + 8 * widC + (r32C >> 2), headC = 4 * g + (r32C & 3); const size_t qrowC = (size_t)b * SEQ + tqC;

    { const int jb = cur >= 8 ? cur - 8 : 0, d0 = jb >> 1, nd = (cur >> 1) - d0 + 1;
      r2 = tile2_load(Kw, Kw + 256, 128 * d0, tidC); tile2_store(lds, 0, r2, tidC);
      __syncthreads();
      for (int dt = 0; dt < nd; ++dt) { const int buf = dt & 1;
          if (dt + 1 < nd) r2 = tile2_load(Kw, Kw + 256, 128 * (d0 + dt + 1), tidC);
#pragma unroll
          for (int sub = 0; sub < 2; ++sub) { const int j = 2 * (d0 + dt) + sub;
              if (j >= jb && j <= cur) {
                  const LAS unsigned char* kb = lds + L_K2 + buf * KBUF2 + sub * 64 * KS; const LAS unsigned char* vb = lds + L_V2 + buf * VBUF2 + sub * 64 * VS;
                  if (j == jb || j == cur) att_step<true>(kb, vb, qr, m, l, ob0, ob1, 64 * j, tqC - 511, tqC, true, r32C, hiC, laneC);
                  else att_step<false>(kb, vb, qr, m, l, ob0, ob1, 64 * j, tqC - 511, tqC, true, r32C, hiC, laneC); } }
          if (dt + 1 < nd) tile2_store(lds, buf ^ 1, r2, tidC);
          __syncthreads(); } }
    { l = swap_sum(l); const float gt2 = gates[qrowC * 48 + headC * 3 + 2]; const float sc = l > 0.f ? gt2 / l : 0.f;
#pragma unroll
      for (int r = 0; r < 16; ++r) { const unsigned u = stash[64 * r]; ob0[r] = bf_lo(u) + sc * ob0[r]; ob1[r] = bf_hi(u) + sc * ob1[r]; } }
    { bf16* orow = O + qrowC * DM + headC * 64 + 4 * hiC;
#pragma unroll
      for (int gi = 0; gi < 4; ++gi) { v2u w; w.x = pk2(ob0[4 * gi], ob0[4 * gi + 1]); w.y = pk2(ob0[4 * gi + 2], ob0[4 * gi + 3]); *(v2u*)(orow + 8 * gi) = w;
          v2u w1; w1.x = pk2(ob1[4 * gi], ob1[4 * gi + 1]); w1.y = pk2(ob1[4 * gi + 2], ob1[4 * gi + 3]); *(v2u*)(orow + 32 + 8 * gi) = w1; } }
    __syncthreads();
}
}

namespace dec {
constexpr int L_SC = 1024, L_PC = 17408, L_RED = 19456, L_OBUF = 19584, L_OFIN = 27776, L_SBASE = 30848, L_NSEL = 30976;
constexpr float NEG = -1e30f;
__device__ __forceinline__ void block_reduce4(float (&v)[4], bool is_max, LAS float* red, int lane, int wave) {
#pragma unroll
    for (int h = 0; h < 4; ++h) v[h] = is_max ? wave_max(v[h]) : wave_sum(v[h]);
    __syncthreads();
    if (lane == 0) {
#pragma unroll
        for (int h = 0; h < 4; ++h) red[wave * 4 + h] = v[h]; }
    __syncthreads();
#pragma unroll
    for (int h = 0; h < 4; ++h) { float a = red[h];
#pragma unroll
        for (int w = 1; w < 8; ++w) a = is_max ? fmaxf(a, red[w * 4 + h]) : a + red[w * 4 + h];
        v[h] = a; }
}
__device__ __forceinline__ void softmax_sc(LAS float* sc, LAS float* red, float (&inv)[4], int tid, int lane, int wave) {
    float mx[4] = {NEG, NEG, NEG, NEG};
    for (int k = tid; k < 1024; k += 512) {
#pragma unroll
        for (int h = 0; h < 4; ++h) mx[h] = fmaxf(mx[h], sc[h * 1024 + k]); }
    block_reduce4(mx, true, red, lane, wave);
    float sm[4] = {0.f, 0.f, 0.f, 0.f};
    for (int k = tid; k < 1024; k += 512) {
#pragma unroll
        for (int h = 0; h < 4; ++h) { const float e = fast_exp2(sc[h * 1024 + k] - mx[h]); sc[h * 1024 + k] = e; sm[h] += e; } }
    block_reduce4(sm, false, red, lane, wave);
#pragma unroll
    for (int h = 0; h < 4; ++h) inv[h] = 1.f / sm[h];
}
struct LdCmp { const bf16* kc; const bf16* vc; int seq, g;
    __device__ __forceinline__ f32x4 operator()(int k, int which, int l16) const { const bf16* p = (which ? vc : kc) + ((size_t)(seq * 512 + k) * 4 + g) * 64 + 4 * l16; const v2u x = *(const v2u*)p; return (f32x4){bf_lo(x.x), bf_hi(x.x), bf_lo(x.y), bf_hi(x.y)}; } };
struct LdSel { const float* csel; const LAS long long* sbase; const float* newrow; int nk;
    __device__ __forceinline__ f32x4 operator()(int k, int which, int l16) const { const float* p = (k < nk - 1) ? csel + sbase[k >> 6] + (size_t)(k & 63) * 512 : newrow; return *(const f32x4*)(p + which * 256 + 4 * l16); } };
struct LdWin { const float* swin; const float* newrow; int seq, g;
    __device__ __forceinline__ f32x4 operator()(int k, int which, int l16) const { const float* p = (k < 511) ? swin + (size_t)(seq * 512 + k + 1) * 512 + g * 64 : newrow; return *(const f32x4*)(p + which * 256 + 4 * l16); } };
template <class Ld>
__device__ __forceinline__ void branch(const Ld& L, int nk, const f32x4 (&q)[4], LAS float* sc, LAS float* red, LAS float* obuf, LAS float* ofin, float (&inv)[4], int tid, int lane, int wave) {
    const int l16 = lane & 15, gq = lane >> 4, nsteps = (nk + 31) >> 5;
    for (int k = tid; k < 4096; k += 512) sc[k] = NEG;
    __syncthreads();
    for (int it0 = 0; it0 < nsteps; it0 += 8) { f32x4 kv[8];
#pragma unroll
        for (int j = 0; j < 8; ++j) { const int k = (it0 + j) * 32 + wave * 4 + gq; kv[j] = (k < nk) ? L(k, 0, l16) : (f32x4){0.f, 0.f, 0.f, 0.f}; }
#pragma unroll
        for (int j = 0; j < 8; ++j) { const int k = (it0 + j) * 32 + wave * 4 + gq; float s[4];
#pragma unroll
            for (int h = 0; h < 4; ++h) { float x = (kv[j].x * q[h].x + kv[j].y * q[h].y) + (kv[j].z * q[h].z + kv[j].w * q[h].w); s[h] = row16_sum(x); }
            if (k < nk && l16 < 4) sc[l16 * 1024 + k] = l16 == 0 ? s[0] : l16 == 1 ? s[1] : l16 == 2 ? s[2] : s[3]; } }
    __syncthreads();
    softmax_sc(sc, red, inv, tid, lane, wave);
    __syncthreads();
    f32x4 acc[4];
#pragma unroll
    for (int h = 0; h < 4; ++h) acc[h] = (f32x4){0.f, 0.f, 0.f, 0.f};
    for (int it0 = 0; it0 < nsteps; it0 += 8) { f32x4 vv[8];
#pragma unroll
        for (int j = 0; j < 8; ++j) { const int k = (it0 + j) * 32 + wave * 4 + gq; vv[j] = (k < nk) ? L(k, 1, l16) : (f32x4){0.f, 0.f, 0.f, 0.f}; }
#pragma unroll
        for (int j = 0; j < 8; ++j) { const int k = (it0 + j) * 32 + wave * 4 + gq; const int kc = k < 1024 ? k : 1023;
#pragma unroll
            for (int h = 0; h < 4; ++h) { const float p = (k < nk) ? sc[h * 1024 + kc] : 0.f; acc[h] += vv[j] * p; } } }
#pragma unroll
    for (int h = 0; h < 4; ++h)
#pragma unroll
        for (int e = 0; e < 4; ++e) { float x = acc[h][e]; x += __shfl_xor(x, 16); x += __shfl_xor(x, 32); acc[h][e] = x; }
    if (gq == 0) {
#pragma unroll
        for (int h = 0; h < 4; ++h) *(LAS f32x4*)(obuf + (wave * 4 + h) * 64 + 4 * l16) = acc[h]; }
    __syncthreads();
    if (tid < 256) { float a = 0.f;
#pragma unroll
        for (int w = 0; w < 8; ++w) a += obuf[w * 256 + tid];
        const int h = tid >> 6; ofin[tid] = a * (h == 0 ? inv[0] : h == 1 ? inv[1] : h == 2 ? inv[2] : inv[3]); }
    __syncthreads();
}
__device__ __forceinline__ void sample_attn_unit(const float* csel, const float* swin, const int* pt, unsigned char* ws, float* out, int seq, int g, LAS unsigned char* lds) {
    int tid_l = threadIdx.x; asm volatile("" : "+v"(tid_l)); const int tid = tid_l, lane = tid & 63, wave = tid >> 6, l16 = lane & 15;
    LAS float* sc = (LAS float*)(lds + L_SC); LAS float* Pc = (LAS float*)(lds + L_PC); LAS float* red = (LAS float*)(lds + L_RED);
    LAS float* obuf = (LAS float*)(lds + L_OBUF); LAS float* ofin = (LAS float*)(lds + L_OFIN); LAS long long* sbase = (LAS long long*)(lds + L_SBASE); LAS int* nselp = (LAS int*)(lds + L_NSEL);
    const float* QS = (const float*)(ws + WS_QS); const float* GS = (const float*)(ws + WS_GS);
    f32x4 q[4];
#pragma unroll
    for (int h = 0; h < 4; ++h) q[h] = *(const f32x4*)(QS + seq * DM + (4 * g + h) * 64 + 4 * l16);
    float inv[4];
    { const LdCmp L{(const bf16*)(ws + WS_KC), (const bf16*)(ws + WS_VC), seq, g}; branch(L, 511, q, sc, red, obuf, ofin, inv, tid, lane, wave); }
    Pc[tid] = tid < 511 ? (sc[tid] * inv[0] + sc[1024 + tid] * inv[1]) + (sc[2048 + tid] * inv[2] + sc[3072 + tid] * inv[3]) : 0.f;
    __syncthreads();
    if (wave == 0) { const int j0 = lane, j1 = lane + 64; const bool c0 = j0 >= 1, c1 = j1 <= 126;
        const float v0 = c0 ? Pc[4 * j0 - 1] + 2.f * (Pc[4 * j0] + Pc[4 * j0 + 1] + Pc[4 * j0 + 2]) + Pc[4 * j0 + 3] : 0.f;
        const float v1 = c1 ? Pc[4 * j1 - 1] + 2.f * (Pc[4 * j1] + Pc[4 * j1 + 1] + Pc[4 * j1 + 2]) + Pc[4 * j1 + 3] : 0.f;
        bool s0, s1; nsa::topk_select(c0, c1, __float_as_uint(v0), __float_as_uint(v1), 13, lane, s0, s1);
        s0 = s0 || j0 == 0; s1 = s1 || j1 == 127;
        unsigned long long b0 = __ballot(s0), b1 = __ballot(s1);
        if (lane == 0) { int n = 0;
            while (b0 && n < 15) { const int j = __builtin_ctzll(b0); b0 &= b0 - 1ull; sbase[n++] = ((long long)pt[seq * 64 + (j >> 1)] * 128 + (j & 1) * 64) * 512 + g * 64; }
            while (b1 && n < 15) { const int j = 64 + __builtin_ctzll(b1); b1 &= b1 - 1ull; sbase[n++] = ((long long)pt[seq * 64 + (j >> 1)] * 128 + (j & 1) * 64) * 512 + g * 64; }
            nselp[0] = n; } }
    __syncthreads();
    { const int nk = nselp[0] * 64 + 1; const LdSel L{csel, sbase, out + O_SELS + seq * 512 + g * 64, nk}; branch(L, nk, q, sc, red, obuf, ofin + 256, inv, tid, lane, wave); }
    { const LdWin L{swin, out + O_WINS + (size_t)(seq * 512 + 511) * 512 + g * 64, seq, g}; branch(L, 512, q, sc, red, obuf, ofin + 512, inv, tid, lane, wave); }
    if (tid < 256) { const int head = 4 * g + (tid >> 6); const float* gp = GS + seq * 48 + head * 3;
        const float o = gp[0] * ofin[tid] + gp[1] * ofin[256 + tid] + gp[2] * ofin[512 + tid];
        ((bf16*)(ws + WS_OS))[seq * DM + head * 64 + (tid & 63)] = (bf16)(pk2(o, 0.f) & 0xffffu); }
    __syncthreads();
}
}

#ifndef ONLY_SITE
#define ONLY_SITE -1
#endif
#define SITE_ON(n) (ONLY_SITE < 0 || ONLY_SITE == (n))
#ifndef PROBE_DUP
#define PROBE_DUP 0
#endif
#define REP(n) for (int rep_ = 0; rep_ < 1 + ((PROBE_DUP >> (n)) & 1); ++rep_)
__global__ void __launch_bounds__(NWAVES * 64, 2) yoco_fwd(Args args) {
    extern __shared__ __attribute__((aligned(16))) unsigned char lds_raw[];
    LAS unsigned char* const lds = (LAS unsigned char*)lds_raw;
    for (int u = threadIdx.x; u < (LDS_BYTES - LDSCTL_OFF) / 4; u += NWAVES * 64) ((LAS unsigned*)(lds + LDSCTL_OFF))[u] = 0u;
    __syncthreads();
    if (threadIdx.x == 0) { LAS unsigned long long* tab = (LAS unsigned long long*)(lds + PTAB_OFF);
#pragma unroll
        for (int i = 0; i < 28; ++i) tab[i] = (unsigned long long)args.in[i];
        tab[28] = (unsigned long long)args.out; tab[29] = (unsigned long long)args.ws; }
    __syncthreads();
    XcdBarrier bar; bar.bar = (unsigned*)((unsigned char*)tab_ptr(lds, 29) + WS_CTL) + CW_BAR; bar.x = 0; bar.st = nullptr;
    if (args.use_bar) bar = xcd_barrier_post(bar.bar, (volatile LAS unsigned*)(lds + MISC_OFF) + 8);
    const int lo = args.ph_lo, hi = args.ph_hi, use_bar = args.use_bar;
    int ph = 0;
#define PH_ON (ph >= lo && ph < hi)
#define PH_END do { if (PH_ON && ph + 1 < hi) { if (use_bar) xcd_barrier(bar); } ++ph; } while (0)
#define MKFRAME Frame F; F.lds = lds; F.MISC = (volatile LAS unsigned*)(lds + MISC_OFF); { int tid_l = threadIdx.x; asm volatile("" : "+v"(tid_l)); F.tid = tid_l; } F.lane = F.tid & 63; F.wave = __builtin_amdgcn_readfirstlane(F.tid >> 6); \
    F.G = gridDim.x; F.gw = blockIdx.x * NWAVES + F.wave; F.NGW = F.G * NWAVES; F.ws = (unsigned char*)tab_ptr(lds, 29); F.out = (float*)tab_ptr(lds, 28); unsigned char* const ws = F.ws; (void)ws

    if (SITE_ON(0) && PH_ON) REP(0) { MKFRAME; prologue_phase(F); }
    PH_END;

    for (int layer = 0; layer < 4; ++layer) {
        if (layer < 2) {
            if (SITE_ON(1) && PH_ON) REP(1) { MKFRAME;
                const bf16* W = (const bf16*)(ws + WS_WUV) + (size_t)layer * 2048 * 1024;
                pg8::Gemm g{(const bf16*)(ws + WS_XN), W, MP, 2048, DM}; pg8::StaticOrder S; S.init(MP, 2048, F.G, (int)blockIdx.x);
                EpiUV E{(bf16*)(ws + WS_U), (bf16*)(ws + WS_V), (float*)(ws + WS_ROWSS), (const float*)(ws + WS_ROWSS2)};
                pg8::gemm_phase<EpiUV, pg8::StaticOrder, true, true>(F.lds, g, S, E);
                SkUV SE{(float*)(ws + WS_USU), (float*)(ws + WS_VSF)};
                skinny_gemm_hs(F.lds, (const float*)(ws + WS_HS), W, 2048, SE);
            }
            PH_END;
            if (SITE_ON(2) && PH_ON) { MKFRAME;
#ifdef PROBE_GATE
                gating_phase(F, layer, (bf16*)(ws + WS_H1));
#endif
                gating_phase(F, layer, (bf16*)(ws + WS_U)); }
            PH_END;
        } else {
            if (SITE_ON(3) && PH_ON) REP(3) { MKFRAME;
                const bool first = layer == 2; const int N = first ? NKVQG : NQG1; const bf16* W = (const bf16*)(ws + (first ? WS_WKVQG : WS_WQG1));
                const float* bg = INF(22) + (layer - 2) * 48;
                pg8::Gemm g{(const bf16*)(ws + WS_XN), W, MP, N, DM}; pg8::StaticOrder S; S.init(MP, N, F.G, (int)blockIdx.x);
                EpiKVQG E{F.out, (bf16*)(ws + WS_ACMP), (bf16*)(ws + WS_KSEL), (bf16*)(ws + WS_KWIN), (bf16*)(ws + WS_Q), (float*)(ws + WS_GATES), bg, first ? 0 : 6, (const float*)(ws + WS_ROWSS2)};
                pg8::gemm_phase<EpiKVQG, pg8::StaticOrder, true, true>(F.lds, g, S, E);
                SkKVQG SE{F.out, (float*)(ws + WS_QS), (float*)(ws + WS_GS), bg, first ? 0 : 1536};
                skinny_gemm_hs(F.lds, (const float*)(ws + WS_HS), W, N, SE);
                if (first) {
                    pg8::Gemm g2{(const bf16*)(ws + WS_ACMP), (const bf16*)(ws + WS_WC1), 2 * ACMP_ROWS, 1024, DM};
                    TBEarlyOrder S2; S2.G = F.G; S2.c = (int)blockIdx.x;
                    EpiTB E2{(bf16*)(ws + WS_TB)};
                    pg8::gemm_phase<EpiTB, TBEarlyOrder, true, true>(F.lds, g2, S2, E2);
                }
            }
            PH_END;
            if (layer == 2) {
                if (SITE_ON(4) && PH_ON) REP(4) { MKFRAME;
                    pg8::Gemm g{(const bf16*)(ws + WS_ACMP), (const bf16*)(ws + WS_WC1F), 2 * ACMP_ROWS, 512, 2048};
                    TBFOrder S; S.G = F.G; S.c = (int)blockIdx.x; S.HB = (const bf16*)(ws + WS_HB); S.W2 = (const bf16*)(ws + WS_WC2); S.KC = (bf16*)(ws + WS_KC); S.VC = (bf16*)(ws + WS_VC);
                    EpiH E{(bf16*)(ws + WS_HB), (const float*)(ws + WS_BIAS1)};
                    pg8::gemm_phase<EpiH, TBFOrder, true, true, 1024, 8192>(F.lds, g, S, E);
                    for (int x = F.gw; x < 512; x += F.NGW) { const int kv = x >> 8, un = 3840 + (x & 255);
                        combine16_tb((const bf16*)(ws + WS_TB + (size_t)kv * WS_TB_STRIDE), (const float*)(ws + WS_BIAS1) + kv * 256, (const bf16*)(ws + WS_WC2) + (size_t)kv * 64 * 256, (bf16*)(ws + (kv ? WS_VC : WS_KC)), un, F.lane); }
                }
                PH_END;
            }
            if (SITE_ON(6) && PH_ON) REP(6) { MKFRAME;
                const bf16* kcp = (const bf16*)(ws + WS_KC) + (size_t)65536 * 64; const bf16* vcp = (const bf16*)(ws + WS_VC) + (size_t)65536 * 64;
                for (int un = blockIdx.x; un < 1024; un += F.G) { const int bx = un & 255, v = (bx & 7) * 32 + (bx >> 3), i = un >> 8, bg = v >> 5, s = v & 31;
                    const int qb = NSA_QB[s * 4 + i];
                    nsa::nsa_unit((const bf16*)(ws + WS_Q), (const float*)(ws + WS_GATES), kcp, vcp, (const bf16*)(ws + WS_KSEL), (const bf16*)(ws + WS_KWIN), (bf16*)(ws + WS_OATT), bg >> 2, bg & 3, qb, F.lds); }
                const float* csel = INF(3); const float* swin = INF(4); const int* pt = (const int*)tab_ptr(lds, 5);
#ifndef PROBE_DEC
#define PROBE_DEC 1
#endif
                for (int rp_ = 0; rp_ < PROBE_DEC; ++rp_)
                for (int un = blockIdx.x; un < NS * 4; un += F.G) dec::sample_attn_unit(csel, swin, pt, ws, F.out, un >> 2, un & 3, F.lds);
            }
            PH_END;
        }
        if (SITE_ON(7) && PH_ON) { MKFRAME;
            const bf16* A = (const bf16*)(ws + (layer < 2 ? WS_U : WS_OATT)); const bf16* W = (layer < 2) ? (const bf16*)(ws + WS_WAO) + (size_t)layer * 1024 * 1024 : (const bf16*)(ws + WS_WBO) + (size_t)(layer - 2) * 1024 * 1024;
            pg8::Gemm g{A, W, MP, DM, DM}; pg8::StaticOrder S; S.init(MP, DM, F.G, (int)blockIdx.x);
            EpiResid E{(bf16*)(ws + WS_XN), (float*)(ws + WS_ROWSS2)};
            pg8::gemm_phase<EpiResid, pg8::StaticOrder, true, true>(F.lds, g, S, E);
            SkResid SE{(float*)(ws + WS_HS)};
            skinny_gemm(F.lds, (const bf16*)(ws + (layer < 2 ? WS_USS : WS_OS)), W, DM, DM, SE);
        }
        PH_END;
        if (SITE_ON(9) && PH_ON) REP(9) { MKFRAME;
            const bf16* W = (const bf16*)(ws + WS_WUP) + (size_t)layer * 4096 * 1024;
            pg8::Gemm g{(const bf16*)(ws + WS_XN), W, MP, FF, DM}; pg8::StaticOrder S; S.init(MP, FF, F.G, (int)blockIdx.x);
            EpiSqRelu E{(bf16*)(ws + WS_H1), FF, (const float*)(ws + WS_ROWSS2)};
            pg8::gemm_phase<EpiSqRelu, pg8::StaticOrder, true, true>(F.lds, g, S, E);
            SkSqRelu SE{(bf16*)(ws + WS_H1S)};
            skinny_gemm_hs(F.lds, (const float*)(ws + WS_HS), W, FF, SE);
        }
        PH_END;
        if (SITE_ON(10) && PH_ON) { MKFRAME;
            const bf16* W = (const bf16*)(ws + WS_WDN) + (size_t)layer * 1024 * 4096;
            pg8::Gemm g{(const bf16*)(ws + WS_H1), W, MP, DM, FF}; pg8::StaticOrder S; S.init(MP, DM, F.G, (int)blockIdx.x);
            EpiResid E{(bf16*)(ws + WS_XN), (float*)(ws + WS_ROWSS2)};
            pg8::gemm_phase<EpiResid, pg8::StaticOrder, true, true>(F.lds, g, S, E);
            SkResid SE{(float*)(ws + WS_HS)};
            skinny_gemm(F.lds, (const bf16*)(ws + WS_H1S), W, FF, DM, SE);
        }
        PH_END;
        if (layer == 3) {
            if (SITE_ON(11) && PH_ON) { MKFRAME;
                float* HP = F.out + O_Y; const float* fg = INF(27); const float* HS = (const float*)(ws + WS_HS);
                for (int m = F.gw; m < MP + NS; m += F.NGW) {
                    if (m < MP) norm_row_bf16((const bf16*)(ws + WS_XN) + (size_t)m * DM, (const float*)(ws + WS_ROWSS2) + (size_t)m * 16, fg, HP + (size_t)m * DM, F.lane);
                    else norm_row_f32(HS + (size_t)(m - MP) * DM, fg, F.out + O_YS + (size_t)(m - MP) * DM, F.lane); }
            }
            PH_END;
        }
    }
#undef PH_ON
#undef PH_END
#undef MKFRAME
}
constexpr int N_PHASES = 1 + 2 * 5 + 6 + 5 + 1;

extern "C" void kernel_launch(void* const* d_in, const int* in_sizes, int n_in, void* d_out, int out_size, void* d_ws, size_t ws_size, hipStream_t stream) {
    static int grid = 0;
    if (grid == 0) {
        if (n_in != 28 || (size_t)out_size != O_END || ws_size < WS_END) { fprintf(stderr, "kernel_launch: unexpected shapes (n_in %d, out %d, ws %zu); nothing launched\n", n_in, out_size, ws_size); grid = -1; return; }
        int dev = 0, cus = 0, per_cu = 0;
        if (hipGetDevice(&dev) != hipSuccess || hipDeviceGetAttribute(&cus, hipDeviceAttributeMultiprocessorCount, dev) != hipSuccess) { grid = -1; return; }
        if (hipFuncSetAttribute((const void*)yoco_fwd, hipFuncAttributeMaxDynamicSharedMemorySize, LDS_BYTES) != hipSuccess) { fprintf(stderr, "kernel_launch: hipFuncSetAttribute failed\n"); grid = -1; return; }
        if (hipOccupancyMaxActiveBlocksPerMultiprocessor(&per_cu, (const void*)yoco_fwd, NWAVES * 64, LDS_BYTES) != hipSuccess || per_cu < 1) { fprintf(stderr, "kernel_launch: occupancy query reports %d blocks per CU\n", per_cu); }
        (void)hipGetLastError();
        grid = cus;
    }
    if (grid < 0) return;
    if (hipMemsetAsync((char*)d_ws + WS_CTL, 0, CTL_ZERO_BYTES, stream) != hipSuccess) return;
    Args a{};
    for (int i = 0; i < 28; ++i) a.in[i] = d_in[i];
    a.out = (float*)d_out; a.ws = (unsigned char*)d_ws; a.pad = 0;
#if MK_PER_PHASE
    for (int p = 0; p < N_PHASES; ++p) { a.ph_lo = p; a.ph_hi = p + 1; a.use_bar = 0; hipLaunchKernelGGL(yoco_fwd, dim3(grid), dim3(NWAVES * 64), LDS_BYTES, stream, a); }
#else
    a.ph_lo = 0; a.ph_hi = N_PHASES; a.use_bar = 1;
    hipLaunchKernelGGL(yoco_fwd, dim3(grid), dim3(NWAVES * 64), LDS_BYTES, stream, a);
#endif
    const hipError_t le = hipPeekAtLastError();
    if (le != hipSuccess) fprintf(stderr, "kernel_launch: launch failed: %s\n", hipGetErrorName(le));
}
```
